# Optimizing an MI355X kernel written in HIP

```python
import jax, jax.numpy as jnp
from jax import lax
import numpy as np

D_MODEL = 1024
BATCH = 2
SEQ = 16384
DEPTH = 1
DEC_BATCH = 32
DEC_SEQ = 64
PAST_LEN = 4096

CHUNK = 64
GMLP_CHUNK = 128
GMLP_GROUPS = 8
GMLP_WIDTH = 1024
GMLP_GROUP_DIM = GMLP_WIDTH // GMLP_GROUPS
MLA_HEADS = 8
Q_LORA = 512
KV_LORA = 512
NOPE_DIM = 128
ROPE_DIM = 64
V_DIM = 128
QK_DIM = NOPE_DIM + ROPE_DIM
ROPE_BASE = 10000.0
ATTN_SCALE = QK_DIM ** -0.5
Q_BLOCK = 128
NEG_INF = -1e30
D_FF = 2816
CONV_W = 3
EPS = 1e-6
OFF_Q = 2 * GMLP_WIDTH
OFF_KV = OFF_Q + Q_LORA
OFF_GATE = OFF_KV + KV_LORA + ROPE_DIM
IN_COLS = OFF_GATE + 2 * D_MODEL

kernel_name = "hybrid_gmlp_mla_convffn_stream_step"


def _rmsnorm(x, g):
    xf = x.astype(jnp.float32)
    y = xf * lax.rsqrt(jnp.mean(xf * xf, axis=-1, keepdims=True) + EPS)
    return (y * g.astype(jnp.float32)).astype(x.dtype)


def _layernorm(x, g, b):
    xf = x.astype(jnp.float32)
    xc = xf - jnp.mean(xf, axis=-1, keepdims=True)
    var = jnp.mean(xc * xc, axis=-1, keepdims=True)
    return (xc * lax.rsqrt(var + EPS) * g.astype(jnp.float32) + b.astype(jnp.float32)).astype(x.dtype)


def _rope(x, pos):
    half = ROPE_DIM // 2
    inv_freq = ROPE_BASE ** (-jnp.arange(half, dtype=jnp.float32) / half)
    ang = pos.astype(jnp.float32)[:, None] * inv_freq[None, :]
    ang = ang.reshape(ang.shape[:1] + (1,) * (x.ndim - 3) + (half,))
    cos, sin = jnp.cos(ang), jnp.sin(ang)
    xf = x.astype(jnp.float32)
    x1, x2 = xf[..., :half], xf[..., half:]
    return jnp.concatenate([x1 * cos - x2 * sin, x1 * sin + x2 * cos], axis=-1).astype(x.dtype)


def _gmlp_branch(uv, ln_g, ln_b, w_s, b_s):
    u, v = jnp.split(jax.nn.gelu(uv), 2, axis=-1)
    v = _layernorm(v, ln_g, ln_b)
    bsz, L, _ = v.shape
    n = min(L, GMLP_CHUNK)
    causal = jnp.tril(jnp.ones((n, n), dtype=bool))
    w = jnp.where(causal, w_s[:, :n, :n], 0)
    vc = v.reshape(bsz, L // n, n, GMLP_GROUPS, GMLP_GROUP_DIM)
    s = jnp.einsum('gts,bnsgc->bntgc', w, vc) + b_s[:, :n].T[:, :, None]
    return u * s.reshape(bsz, L, GMLP_WIDTH), v


def _mla_qkv(q_lat, kv_lat, pos, q_norm_g, w_uq, kv_norm_g):
    q = jnp.einsum('bsr,rhd->bshd', _rmsnorm(q_lat, q_norm_g), w_uq)
    q = jnp.concatenate([q[..., :NOPE_DIM], _rope(q[..., NOPE_DIM:], pos)], axis=-1)
    c_kv = _rmsnorm(kv_lat[..., :KV_LORA], kv_norm_g)
    k_rope = _rope(kv_lat[..., KV_LORA:], pos)
    return q, c_kv, k_rope


def _expand_kv(c_kv, k_rope, w_uk, w_uv):
    k_nope = jnp.einsum('bsc,chd->bshd', c_kv, w_uk)
    k_r = jnp.broadcast_to(k_rope[:, :, None, :], k_nope.shape[:3] + (ROPE_DIM,))
    v = jnp.einsum('bsc,chd->bshd', c_kv, w_uv)
    return jnp.concatenate([k_nope, k_r], axis=-1), v


def _attend(q, q_pos, k, v, k_pos):
    s = jnp.einsum('bqhd,bkhd->bhqk', q, k).astype(jnp.float32) * ATTN_SCALE
    visible = (k_pos[None, :] // CHUNK) <= (q_pos[:, None] // CHUNK)
    s = jnp.where(visible, s, NEG_INF)
    p = jax.nn.softmax(s, axis=-1).astype(v.dtype)
    return jnp.einsum('bhqk,bkhd->bqhd', p, v)


def _conv_ffn(h, prev, w_up, conv_w, conv_b, w_down):
    up = h @ w_up
    L = up.shape[1]
    full = jnp.concatenate([prev, up], axis=1)
    c = conv_b + sum(full[:, i:i + L] * conv_w[i] for i in range(CONV_W))
    val, gate = jnp.split(c, 2, axis=-1)
    return (jax.nn.silu(gate) * val) @ w_down, full[:, L:]


def _layer(x, pos, past_ckv, past_krope, past_conv,
           norm_mix_g, w_in, gmlp_ln_g, gmlp_ln_b, gmlp_w_s, gmlp_b_s,
           mla_q_norm_g, mla_w_uq, mla_kv_norm_g, mla_w_uk, mla_w_uv,
           w_proj_a, w_proj_b, w_out, norm_ffn_g, ffn_w_up, ffn_conv_w, ffn_conv_b, ffn_w_down):
    bsz, L, _ = x.shape
    z = _rmsnorm(x, norm_mix_g) @ w_in
    gates = jax.nn.sigmoid(z[..., OFF_GATE:])
    a_out, v_rows = _gmlp_branch(z[..., :OFF_Q], gmlp_ln_g, gmlp_ln_b, gmlp_w_s, gmlp_b_s)
    q, c_kv, k_rope = _mla_qkv(z[..., OFF_Q:OFF_KV], z[..., OFF_KV:OFF_GATE], pos,
                               mla_q_norm_g, mla_w_uq, mla_kv_norm_g)
    if past_ckv is None:
        k, v = _expand_kv(c_kv, k_rope, mla_w_uk, mla_w_uv)
        nb = L // Q_BLOCK
        qb = jnp.moveaxis(q.reshape(bsz, nb, Q_BLOCK, MLA_HEADS, QK_DIM), 1, 0)
        pb = pos.reshape(nb, Q_BLOCK)
        ob = lax.map(lambda qp: _attend(qp[0], qp[1], k, v, pos), (qb, pb))
        attn = jnp.moveaxis(ob, 0, 1).reshape(bsz, L, MLA_HEADS * V_DIM)
    else:
        k, v = _expand_kv(jnp.concatenate([past_ckv, c_kv], axis=1),
                          jnp.concatenate([past_krope, k_rope], axis=1), mla_w_uk, mla_w_uv)
        k_pos = jnp.arange(past_ckv.shape[1] + L, dtype=jnp.int32)
        attn = _attend(q, pos, k, v, k_pos).reshape(bsz, L, MLA_HEADS * V_DIM)
    merged = gates[..., :D_MODEL] * (a_out @ w_proj_a) + gates[..., D_MODEL:] * (attn @ w_proj_b)
    h = x + merged @ w_out
    ffn_out, conv_rows = _conv_ffn(_rmsnorm(h, norm_ffn_g), past_conv,
                                   ffn_w_up, ffn_conv_w, ffn_conv_b, ffn_w_down)
    return h + ffn_out, c_kv, k_rope, conv_rows, v_rows


def setup_inputs(seed: int = 0) -> dict:
    key = jax.random.key(seed)
    ks = jax.random.split(key, 32)

    def nrm(k, shape, scale=1.0):
        return jax.random.normal(k, shape, jnp.float32) * scale

    return {
        "x_prompt": nrm(ks[0], (BATCH, SEQ, D_MODEL)),
        "x_sample": nrm(ks[1], (DEC_BATCH, DEC_SEQ, D_MODEL)),
        "cache_mla_ckv": nrm(ks[2], (DEPTH, DEC_BATCH, PAST_LEN, KV_LORA)),
        "cache_mla_krope": nrm(ks[3], (DEPTH, DEC_BATCH, PAST_LEN, ROPE_DIM)),
        "state_ffn_conv": nrm(ks[4], (DEPTH, DEC_BATCH, CONV_W - 1, 2 * D_FF)),
        "norm_mix_g": 1.0 + nrm(ks[5], (DEPTH, D_MODEL), 0.02),
        "w_in": nrm(ks[6], (DEPTH, D_MODEL, IN_COLS), D_MODEL ** -0.5),
        "gmlp_ln_g": 1.0 + nrm(ks[7], (DEPTH, GMLP_WIDTH), 0.02),
        "gmlp_ln_b": nrm(ks[8], (DEPTH, GMLP_WIDTH), 0.02),
        "gmlp_w_s": nrm(ks[9], (DEPTH, GMLP_GROUPS, GMLP_CHUNK, GMLP_CHUNK), GMLP_CHUNK ** -0.5),
        "gmlp_b_s": 1.0 + nrm(ks[10], (DEPTH, GMLP_GROUPS, GMLP_CHUNK), 0.02),
        "mla_q_norm_g": 1.0 + nrm(ks[11], (DEPTH, Q_LORA), 0.02),
        "mla_w_uq": nrm(ks[12], (DEPTH, Q_LORA, MLA_HEADS, QK_DIM), Q_LORA ** -0.5),
        "mla_kv_norm_g": 1.0 + nrm(ks[13], (DEPTH, KV_LORA), 0.02),
        "mla_w_uk": nrm(ks[14], (DEPTH, KV_LORA, MLA_HEADS, NOPE_DIM), KV_LORA ** -0.5),
        "mla_w_uv": nrm(ks[15], (DEPTH, KV_LORA, MLA_HEADS, V_DIM), KV_LORA ** -0.5),
        "w_proj_a": nrm(ks[16], (DEPTH, GMLP_WIDTH, D_MODEL), GMLP_WIDTH ** -0.5),
        "w_proj_b": nrm(ks[17], (DEPTH, MLA_HEADS * V_DIM, D_MODEL), (MLA_HEADS * V_DIM) ** -0.5),
        "w_out": nrm(ks[18], (DEPTH, D_MODEL, D_MODEL), D_MODEL ** -0.5),
        "norm_ffn_g": 1.0 + nrm(ks[19], (DEPTH, D_MODEL), 0.02),
        "ffn_w_up": nrm(ks[20], (DEPTH, D_MODEL, 2 * D_FF), D_MODEL ** -0.5),
        "ffn_conv_w": nrm(ks[21], (DEPTH, CONV_W, 2 * D_FF), CONV_W ** -0.5),
        "ffn_conv_b": nrm(ks[22], (DEPTH, 2 * D_FF), 0.02),
        "ffn_w_down": nrm(ks[23], (DEPTH, D_FF, D_MODEL), D_FF ** -0.5),
        "final_norm_g": 1.0 + nrm(ks[24], (D_MODEL,), 0.02),
    }


def reference(x_prompt, x_sample, cache_mla_ckv, cache_mla_krope, state_ffn_conv,
              norm_mix_g, w_in, gmlp_ln_g, gmlp_ln_b, gmlp_w_s, gmlp_b_s,
              mla_q_norm_g, mla_w_uq, mla_kv_norm_g, mla_w_uk, mla_w_uv,
              w_proj_a, w_proj_b, w_out, norm_ffn_g, ffn_w_up, ffn_conv_w, ffn_conv_b, ffn_w_down,
              final_norm_g):
    seq = x_prompt.shape[1]
    dec_seq = x_sample.shape[1]
    past_len = cache_mla_ckv.shape[2]
    pos_p = jnp.arange(seq, dtype=jnp.int32)
    pos_s = past_len + jnp.arange(dec_seq, dtype=jnp.int32)
    conv_zero = jnp.zeros((x_prompt.shape[0], CONV_W - 1, 2 * D_FF), x_prompt.dtype)

    y_p, y_s = x_prompt, x_sample
    ckv_p, kr_p, cv_p, ckv_s, kr_s, cv_s, gv_s = [], [], [], [], [], [], []
    for l in range(DEPTH):
        w = (norm_mix_g[l], w_in[l], gmlp_ln_g[l], gmlp_ln_b[l], gmlp_w_s[l], gmlp_b_s[l],
             mla_q_norm_g[l], mla_w_uq[l], mla_kv_norm_g[l], mla_w_uk[l], mla_w_uv[l],
             w_proj_a[l], w_proj_b[l], w_out[l], norm_ffn_g[l], ffn_w_up[l], ffn_conv_w[l],
             ffn_conv_b[l], ffn_w_down[l])
        y_p, c1, k1, v1, _ = _layer(y_p, pos_p, None, None, conv_zero, *w)
        y_s, c2, k2, v2, g2 = _layer(y_s, pos_s, cache_mla_ckv[l], cache_mla_krope[l],
                                     state_ffn_conv[l], *w)
        ckv_p.append(c1); kr_p.append(k1); cv_p.append(v1)
        ckv_s.append(c2); kr_s.append(k2); cv_s.append(v2); gv_s.append(g2)

    y_prompt = _rmsnorm(y_p, final_norm_g)
    y_sample = _rmsnorm(y_s, final_norm_g)
    return (y_prompt, y_sample,
            jnp.stack(ckv_p), jnp.stack(kr_p), jnp.stack(cv_p),
            jnp.stack(ckv_s), jnp.stack(kr_s), jnp.stack(cv_s), jnp.stack(gv_s))
```

```cpp
#include <hip/hip_runtime.h>
#include <hip/hip_cooperative_groups.h>
#include <cstdio>
#include <cstdint>
namespace cg = cooperative_groups;

typedef unsigned short bf16_t;
typedef short bf16x8 __attribute__((ext_vector_type(8)));
typedef short s16x4 __attribute__((ext_vector_type(4)));
typedef float f32x4 __attribute__((ext_vector_type(4)));
typedef float f32x16 __attribute__((ext_vector_type(16)));
typedef unsigned u32x4 __attribute__((ext_vector_type(4)));
typedef unsigned u32x2 __attribute__((ext_vector_type(2)));
#define LAS __attribute__((address_space(3)))
#define DI __device__ __forceinline__

constexpr int TP = 32768, TS = 2048, TT = TP + TS;
constexpr int SEQ = 16384, PAST = 4096, NBS = 32;
constexpr int KVS = 4224;
constexpr int RALL = TP + NBS * KVS;
constexpr int NZ = 3328;
constexpr int DFF = 2816, DFF2 = 5632;
constexpr int OFFG = 3136;
constexpr int INC = 5184;

constexpr size_t OFF_WIN = 0;
constexpr size_t OFF_WG = OFF_WIN + (size_t)NZ * 1024 * 2;
constexpr size_t OFF_WUQ = OFF_WG + (size_t)2048 * 1024 * 2;
constexpr size_t OFF_WKV = OFF_WUQ + (size_t)1536 * 512 * 2;
constexpr size_t OFF_WPA = OFF_WKV + (size_t)2048 * 512 * 2;
constexpr size_t OFF_WPB = OFF_WPA + (size_t)1024 * 1024 * 2;
constexpr size_t OFF_WOUT = OFF_WPB + (size_t)1024 * 1024 * 2;
constexpr size_t OFF_WUP = OFF_WOUT + (size_t)1024 * 1024 * 2;
constexpr size_t OFF_WDN = OFF_WUP + (size_t)DFF2 * 1024 * 2;
constexpr size_t OFF_WSB = OFF_WDN + (size_t)1024 * DFF * 2;
constexpr size_t OFF_ROPE = OFF_WSB + (size_t)8 * 128 * 128 * 2;
constexpr size_t OFF_CNT = OFF_ROPE + (size_t)16384 * 32 * 8;
constexpr size_t OFF_XN = OFF_CNT + 256;
constexpr size_t OFF_UA = OFF_XN + (size_t)TT * 1024 * 2;
constexpr size_t OFF_CKV = OFF_UA + (size_t)TT * 1024 * 2;
constexpr size_t OFF_KB = OFF_CKV + (size_t)RALL * 512 * 2;
constexpr size_t OFF_VB = OFF_KB + (size_t)RALL * 1024 * 2;
constexpr size_t OFF_BAR = OFF_VB + (size_t)RALL * 1024 * 2;
constexpr size_t BAR_BYTES = 16384;
constexpr size_t OFF_SSQ = OFF_BAR + BAR_BYTES;
constexpr size_t OFF_TFLAG = OFF_SSQ + (size_t)TT * 4;
constexpr size_t OFF_STAT = OFF_TFLAG + 4096;
constexpr size_t WS_END = OFF_STAT + (size_t)3 * TT * 4;
constexpr size_t OFF_TPART = OFF_CKV;
constexpr size_t OFF_ATTN = OFF_CKV;
constexpr size_t OFF_V = OFF_KB;
constexpr size_t OFF_QLAT = OFF_KB + (size_t)TT * 1024 * 2;
constexpr size_t OFF_T1 = OFF_KB;
constexpr size_t OFF_T2 = OFF_KB + (size_t)TT * 1024 * 4;
constexpr size_t OFF_MERGED = OFF_VB;
constexpr size_t OFF_HN = OFF_XN;
constexpr size_t OFF_UP = OFF_KB;
constexpr size_t OFF_ACT = OFF_KB + (size_t)400 * 1024 * 1024;
static_assert(WS_END <= ((size_t)1 << 30), "workspace map exceeds 1 GiB");
static_assert((size_t)TT * 1024 * 4 <= (size_t)RALL * 512 * 2, "T does not fit the ckv region");
static_assert(OFF_T2 + (size_t)TT * 1024 * 4 <= OFF_VB, "T2 overlaps merged");
static_assert((size_t)TT * DFF2 * 2 <= (size_t)400 * 1024 * 1024, "up overlaps act");
static_assert(OFF_ACT + (size_t)TT * DFF * 2 <= WS_END, "act out of range");

constexpr size_t O_Y = 0, O_CKVP = 35651584, O_KRP = 52428800, O_CONVP = 54525952, O_CKVS = 54548480, O_KRS = 55597056,
                 O_CONVS = 55728128, O_GV = 56088576, O_END = 58185728;
constexpr size_t OB_Q = 0, OB_KR = (size_t)TT * 1536 * 2;
static_assert(OB_KR + (size_t)RALL * 64 * 2 <= (size_t)TP * 1024 * 4, "d_out scratch too large");

struct Params { const float* in[25]; float* out; unsigned char* ws; };

DI int get_tid() { int t = threadIdx.x; asm volatile("" : "+v"(t)); return t; }
DI int get_bid() { int b = blockIdx.x; asm volatile("" : "+s"(b)); return b; }
typedef __bf16 bf16x2_t __attribute__((ext_vector_type(2)));
typedef float f32x2_t __attribute__((ext_vector_type(2)));
DI unsigned cvt_pk(float lo, float hi) { const f32x2_t v = {lo, hi}; const bf16x2_t r = __builtin_convertvector(v, bf16x2_t); return __builtin_bit_cast(unsigned, r); }
DI float bf2f(unsigned short b) { return __uint_as_float(((unsigned)b) << 16); }
DI bf16_t f2bf(float f) { return (bf16_t)(cvt_pk(f, 0.f) & 0xffffu); }
DI float bflo(unsigned w) { return __uint_as_float(w << 16); }
DI float bfhi(unsigned w) { return __uint_as_float(w & 0xffff0000u); }
DI void st_bf8(bf16_t* p, f32x4 a, f32x4 b) { u32x4 w; w.x = cvt_pk(a[0], a[1]); w.y = cvt_pk(a[2], a[3]); w.z = cvt_pk(b[0], b[1]); w.w = cvt_pk(b[2], b[3]); *(u32x4*)p = w; }
DI float wave_sum(float v) {
#pragma unroll
  for (int o = 32; o; o >>= 1) v += __shfl_xor(v, o);
  return v;
}
DI float sigmoidf_(float x) { return __builtin_amdgcn_rcpf(1.f + __builtin_amdgcn_exp2f(-1.4426950408889634f * x)); }
DI float gelu_tanh(float x) { const float y = 1.5957691216057308f * (x + 0.044715f * x * x * x); return x * sigmoidf_(y); }
DI const float* xrow(const Params& p, int t) { return t < TP ? p.in[0] + (size_t)t * 1024 : p.in[1] + (size_t)(t - TP) * 1024; }
DI int tok_pos(int t) { return t < TP ? (t & (SEQ - 1)) : PAST + ((t - TP) & 63); }
DI int tok_kvrow(int t) { if (t < TP) return t; const int ts = t - TP; return TP + (ts >> 6) * KVS + PAST + (ts & 63); }
DI float* ckv_out(float* out, int t) { return t < TP ? out + O_CKVP + (size_t)t * 512 : out + O_CKVS + (size_t)(t - TP) * 512; }
DI float* kr_out(float* out, int t) { return t < TP ? out + O_KRP + (size_t)t * 64 : out + O_KRS + (size_t)(t - TP) * 64; }

namespace pg8 {
constexpr int BM = 256, BK = 64, HALF = 128, HTB = HALF * BK * 2, STAGE_BYTES = 8 * HTB, NXCD = 8, WGM = 8;
DI int lds_byte(int r, int c) { const int st = (r >> 4) * 2 + (c >> 5), rr = r & 15, cc = c & 31, ob = rr * 64 + cc * 2; return st * 1024 + (ob ^ (((ob >> 9) & 1) << 5)); }
DI void stage_rc(int b, int& R, int& C) { const int st = b / 1024, sb = b % 1024, swz = sb ^ (((sb >> 9) & 1) << 5); R = (st >> 1) * 16 + swz / 64; C = (st & 1) * 32 + (swz % 64) / 2; }
DI int perm32(int rho) { const int n = rho >> 4, i = rho & 15; return 8 * (i >> 2) + 4 * n + (i & 3); }
struct Unit { int pm, pn, kofs; };
struct Gemm { const bf16_t* A; const bf16_t* Bt; int lda, ldb, M, N, K; const bf16_t* A2; const bf16_t* Bt2; int ns; };
struct StaticOrder {
  int nM, nN, nwg, G, c;
  int lim, tail;
  DI void init(int M, int N, int G_, int c_) { nM = M / BM; nN = N / BM; nwg = nM * nN; G = G_; c = c_; lim = nwg; tail = 0; }
  DI bool next(int i, Unit& u) const {
    long L = (long)i * G + c; u.kofs = 0;
    if (tail) { if (i > 0 || (c >> 1) >= nwg - lim) return false; L = lim + (c >> 1); u.kofs = (c & 1) * tail; }
    else if (L >= lim) return false;
    int wgid = (int)L; { const int q = nwg / NXCD, r = nwg % NXCD, xcd = wgid % NXCD, off = wgid / NXCD; wgid = (xcd < r ? xcd * (q + 1) : r * (q + 1) + (xcd - r) * q) + off; }
    const int nig = WGM * nN, gid = wgid / nig, fm = gid * WGM, gsz = (nM - fm) < WGM ? (nM - fm) : WGM;
    u.pm = fm + ((wgid % nig) % gsz); u.pn = (wgid % nig) / gsz; return true;
  }
};
template <class Epi>
DI void gemm_phase(LAS unsigned char* lds, const Gemm g, const StaticOrder& S, const Epi& E) {
  const int tid = get_tid(), wid = __builtin_amdgcn_readfirstlane(tid >> 6), lane = tid & 63, wr = wid >> 2, wc = wid & 3, fr = lane & 15, fq = lane >> 4;
  const int K = g.K, nt = K / BK;
  unsigned voffA[2], voffB[2];
#pragma unroll
  for (int i = 0; i < 2; ++i) { int R, C; stage_rc(tid * 16 + i * 8192, R, C); const int Rb = (R & ~31) + perm32(R & 31);
    voffA[i] = (unsigned)(R * g.lda + C) * 2u; voffB[i] = (unsigned)(Rb * g.ldb + C) * 2u; }
  const size_t kstep = (size_t)(BK * 2);
  const size_t hstepA = (size_t)HALF * g.lda * 2, hstepB = (size_t)HALF * g.ldb * 2;
  const size_t tstepA = 2 * hstepA, tstepB = 2 * hstepB;
  const unsigned ldsw = (unsigned)wid * 1024u;
  const int aoff = lds_byte(wr * 64 + fr, fq * 8), boff = lds_byte(wc * 32 + fr, fq * 8);
#define PG8_SA(b, h) (((b) * 2 + (h)) * HTB)
#define PG8_SB(b, h) ((4 + (b) * 2 + (h)) * HTB)
#define PG8_STAGE(bufoff, gbase, voff) do { _Pragma("unroll") for (int _i = 0; _i < 2; ++_i) \
    __builtin_amdgcn_global_load_lds((const unsigned*)((const char*)(gbase) + (voff)[_i]), (LAS unsigned*)(lds + (bufoff) + ldsw + _i * 8192), 16, 0, 0); } while (0)
#define PG8_LDA(dst, b, h) do { _Pragma("unroll") for (int m = 0; m < 4; ++m) _Pragma("unroll") for (int k = 0; k < 2; ++k) dst[m][k] = *(const LAS bf16x8*)(lds + PG8_SA(b, h) + aoff + m * 2048 + k * 1024); } while (0)
#define PG8_LDB(dst, b, h) do { _Pragma("unroll") for (int n = 0; n < 2; ++n) _Pragma("unroll") for (int k = 0; k < 2; ++k) dst[n][k] = *(const LAS bf16x8*)(lds + PG8_SB(b, h) + boff + n * 2048 + k * 1024); } while (0)
#define PG8_MMA(ai, bj, At, Bt) do { __builtin_amdgcn_s_setprio(1); _Pragma("unroll") for (int m = 0; m < 4; ++m) _Pragma("unroll") for (int n = 0; n < 2; ++n) _Pragma("unroll") for (int k = 0; k < 2; ++k) \
    acc[ai][bj][m][n] = __builtin_amdgcn_mfma_f32_16x16x32_bf16(Bt[n][k], At[m][k], acc[ai][bj][m][n], 0, 0, 0); __builtin_amdgcn_s_setprio(0); } while (0)
#define PG8_WAIT_V(n) asm volatile("s_waitcnt vmcnt(" #n ")" ::: "memory")
#define PG8_WAIT_L(n) asm volatile("s_waitcnt lgkmcnt(" #n ")" ::: "memory")
#define PG8_BAR __builtin_amdgcn_s_barrier()
#define PG8_SCHED __builtin_amdgcn_sched_barrier(0)
  Unit cur, nxt; int ui = 0;
  if (!S.next(0, cur)) return;
  f32x4 acc[2][2][4][2];
#pragma unroll
  for (int a = 0; a < 2; ++a)
#pragma unroll
    for (int b = 0; b < 2; ++b)
#pragma unroll
      for (int m = 0; m < 4; ++m)
#pragma unroll
        for (int n = 0; n < 2; ++n) acc[a][b][m][n] = (f32x4){0.f, 0.f, 0.f, 0.f};
  bf16x8 At[4][2], B0[2][2], B1[2][2];
  const char* cA = (const char*)g.A + (size_t)cur.pm * tstepA + (size_t)cur.kofs * 2; const char* cB = (const char*)g.Bt + (size_t)cur.pn * tstepB + (size_t)cur.kofs * 2;
  const int ns = Epi::SPLIT ? g.ns : nt;
  PG8_STAGE(PG8_SB(0, 0), cB, voffB); PG8_STAGE(PG8_SA(0, 0), cA, voffA); PG8_STAGE(PG8_SB(0, 1), cB + hstepB, voffB); PG8_STAGE(PG8_SA(0, 1), cA + hstepA, voffA);
  if (wr == 1) PG8_BAR;
  PG8_WAIT_V(4); PG8_BAR;
  PG8_STAGE(PG8_SB(1, 0), cB + kstep, voffB); PG8_STAGE(PG8_SA(1, 0), cA + kstep, voffA); PG8_STAGE(PG8_SB(1, 1), cB + hstepB + kstep, voffB);
  PG8_WAIT_V(6); PG8_BAR;
  for (;;) {
    const bool has_next = S.next(ui + 1, nxt);
    const char* nA = has_next ? (const char*)g.A + (size_t)nxt.pm * tstepA + (size_t)nxt.kofs * 2 : cA; const char* nB = has_next ? (const char*)g.Bt + (size_t)nxt.pn * tstepB + (size_t)nxt.kofs * 2 : cB;
    for (int t = 0; t < nt; t += 2) {
      const bool last = (t == nt - 2);
      const char* a1 = (Epi::SPLIT && t >= ns) ? (const char*)g.A2 + (size_t)cur.pm * tstepA + (size_t)(t + 1 - ns) * kstep : cA + (size_t)(t + 1) * kstep;
      const char* a2; const char* b2;
      if (last) { a2 = nA; b2 = nB; }
      else if (Epi::SPLIT && t + 2 >= ns) { a2 = (const char*)g.A2 + (size_t)cur.pm * tstepA + (size_t)(t + 2 - ns) * kstep; b2 = (const char*)g.Bt2 + (size_t)cur.pn * tstepB + (size_t)(t + 2 - ns) * kstep; }
      else { a2 = cA + (size_t)(t + 2) * kstep; b2 = cB + (size_t)(t + 2) * kstep; }
      if constexpr (Epi::SPLIT) { if (t == ns) E.mid(acc, cur, wr, wc, fr, fq); }
      const char* a3 = a2 + kstep; const char* b3 = b2 + kstep;
      PG8_LDB(B0, 0, 0); PG8_SCHED; PG8_LDA(At, 0, 0); PG8_STAGE(PG8_SA(1, 1), a1 + hstepA, voffA);
      PG8_WAIT_L(8); PG8_BAR; PG8_WAIT_L(0); PG8_MMA(0, 0, At, B0); PG8_BAR; PG8_SCHED;
      PG8_LDB(B1, 0, 1); PG8_STAGE(PG8_SB(0, 0), b2, voffB);
      PG8_BAR; PG8_WAIT_L(0); PG8_MMA(0, 1, At, B1); PG8_BAR;
      PG8_LDA(At, 0, 1); PG8_STAGE(PG8_SA(0, 0), a2, voffA);
      PG8_BAR; PG8_WAIT_L(0); PG8_MMA(1, 0, At, B0); PG8_BAR; PG8_SCHED;
      PG8_STAGE(PG8_SB(0, 1), b2 + hstepB, voffB);
      PG8_WAIT_V(6); PG8_BAR; PG8_MMA(1, 1, At, B1); PG8_BAR;
      PG8_LDB(B0, 1, 0); PG8_SCHED; PG8_LDA(At, 1, 0); PG8_STAGE(PG8_SA(0, 1), a2 + hstepA, voffA);
      PG8_WAIT_L(8); PG8_BAR; PG8_WAIT_L(0); PG8_MMA(0, 0, At, B0); PG8_BAR; PG8_SCHED;
      PG8_LDB(B1, 1, 1); PG8_STAGE(PG8_SB(1, 0), b3, voffB);
      PG8_BAR; PG8_WAIT_L(0); PG8_MMA(0, 1, At, B1); PG8_BAR;
      PG8_LDA(At, 1, 1); PG8_STAGE(PG8_SA(1, 0), a3, voffA);
      PG8_BAR; PG8_WAIT_L(0); PG8_MMA(1, 0, At, B0); PG8_BAR; PG8_SCHED;
      PG8_STAGE(PG8_SB(1, 1), b3 + hstepB, voffB);
      PG8_WAIT_V(6); PG8_BAR; PG8_MMA(1, 1, At, B1); PG8_BAR;
    }
    E(acc, cur, wr, wc, fr, fq);
    if (!has_next) break;
#pragma unroll
    for (int a = 0; a < 2; ++a)
#pragma unroll
      for (int b = 0; b < 2; ++b)
#pragma unroll
        for (int m = 0; m < 4; ++m)
#pragma unroll
          for (int n = 0; n < 2; ++n) acc[a][b][m][n] = (f32x4){0.f, 0.f, 0.f, 0.f};
    cur = nxt; cA = nA; cB = nB; ++ui;
  }
  PG8_WAIT_V(0);
  if (wr == 0) PG8_BAR;
  PG8_BAR;
#undef PG8_SA
#undef PG8_SB
#undef PG8_STAGE
#undef PG8_LDA
#undef PG8_LDB
#undef PG8_MMA
#undef PG8_WAIT_V
#undef PG8_WAIT_L
#undef PG8_BAR
#undef PG8_SCHED
}
template <class F>
DI void epi_iter(const f32x4 (&acc)[2][2][4][2], const Unit& u, int wr, int wc, int fr, int fq, F&& f) {
  const int row0 = u.pm * BM + wr * 64 + fr, col0 = u.pn * BM + wc * 32 + 8 * fq;
#pragma unroll
  for (int ai = 0; ai < 2; ++ai)
#pragma unroll
    for (int m = 0; m < 4; ++m)
#pragma unroll
      for (int bj = 0; bj < 2; ++bj) f(row0 + ai * HALF + m * 16, col0 + bj * HALF, acc[ai][bj][m][0], acc[ai][bj][m][1]);
}
}
using pg8::Unit;

DI void rope8(f32x4& a, f32x4& b, const float2* cs) {
  const float2 c0 = cs[0], c1 = cs[1], c2 = cs[2], c3 = cs[3];
  f32x4 ra, rb;
  ra[0] = a[0] * c0.x - a[1] * c0.y; ra[1] = a[0] * c0.y + a[1] * c0.x;
  ra[2] = a[2] * c1.x - a[3] * c1.y; ra[3] = a[2] * c1.y + a[3] * c1.x;
  rb[0] = b[0] * c2.x - b[1] * c2.y; rb[1] = b[0] * c2.y + b[1] * c2.x;
  rb[2] = b[2] * c3.x - b[3] * c3.y; rb[3] = b[2] * c3.y + b[3] * c3.x;
  a = ra; b = rb;
}

struct EpiZ {
  static constexpr bool SPLIT = false;
  bf16_t* ua; bf16_t* v; bf16_t* qlat; float* out; bf16_t* krall; const float2* rope; float* stat;
  DI void operator()(const f32x4 (&acc)[2][2][4][2], const Unit& u, int wr, int wc, int fr, int fq) const {
    const int pn = u.pn;
    if (pn < 4) {
      pg8::epi_iter(acc, u, wr, wc, fr, fq, [&](int row, int col, f32x4 a, f32x4 b) {
#pragma unroll
        for (int j = 0; j < 4; ++j) { a[j] = gelu_tanh(a[j]); b[j] = gelu_tanh(b[j]); }
        st_bf8(ua + (size_t)row * 1024 + col, a, b); });
    } else if (pn < 10) {
      const bool isv = pn < 8;
      const int row0 = u.pm * 256 + wr * 64 + fr, col0 = u.pn * 256 + wc * 32 + 8 * fq;
#pragma unroll
      for (int ai = 0; ai < 2; ++ai)
#pragma unroll
        for (int m = 0; m < 4; ++m) {
          const int row = row0 + ai * 128 + m * 16; float s1 = 0.f, s2 = 0.f;
#pragma unroll
          for (int bj = 0; bj < 2; ++bj) { const int col = col0 + bj * 128; f32x4 a = acc[ai][bj][m][0], b = acc[ai][bj][m][1];
            if (isv) {
#pragma unroll
              for (int j = 0; j < 4; ++j) { a[j] = gelu_tanh(a[j]); b[j] = gelu_tanh(b[j]); }
              st_bf8(v + (size_t)row * 1024 + (col - 1024), a, b);
            } else st_bf8(qlat + (size_t)row * 512 + (col - 2048), a, b);
            s1 += a[0] + a[1] + a[2] + a[3] + b[0] + b[1] + b[2] + b[3];
            s2 += a[0] * a[0] + a[1] * a[1] + a[2] * a[2] + a[3] * a[3] + b[0] * b[0] + b[1] * b[1] + b[2] * b[2] + b[3] * b[3]; }
          s1 += __shfl_xor(s1, 16); s1 += __shfl_xor(s1, 32); s2 += __shfl_xor(s2, 16); s2 += __shfl_xor(s2, 32);
          if (fq == 0) { if (isv) { atomicAdd(stat + row, s1); atomicAdd(stat + TT + row, s2); } else atomicAdd(stat + 2 * TT + row, s2); }
        }
    } else if (pn < 12) {
      pg8::epi_iter(acc, u, wr, wc, fr, fq, [&](int row, int col, f32x4 a, f32x4 b) { float* o = ckv_out(out, row) + (col - 2560); *(f32x4*)o = a; *(f32x4*)(o + 4) = b; });
    } else {
      pg8::epi_iter(acc, u, wr, wc, fr, fq, [&](int row, int col, f32x4 a, f32x4 b) {
        const int pcol = col - 3072;
        if (pcol < 64) {
          const int i0 = pcol >> 1;
          rope8(a, b, rope + (size_t)tok_pos(row) * 32 + i0);
          float* ko = kr_out(out, row);
          ko[i0] = a[0]; ko[32 + i0] = a[1]; ko[i0 + 1] = a[2]; ko[33 + i0] = a[3];
          ko[i0 + 2] = b[0]; ko[34 + i0] = b[1]; ko[i0 + 3] = b[2]; ko[35 + i0] = b[3];
          st_bf8(krall + (size_t)tok_kvrow(row) * 64 + pcol, a, b);
        } });
    }
  }
};
struct EpiQ {
  static constexpr bool SPLIT = false;
  bf16_t* q; const float2* rope; const float* qsq;
  DI void operator()(const f32x4 (&acc)[2][2][4][2], const Unit& u, int wr, int wc, int fr, int fq) const {
    pg8::epi_iter(acc, u, wr, wc, fr, fq, [&](int row, int col, f32x4 a, f32x4 b) {
      const float rs = rsqrtf(qsq[row] * (1.f / 512.f) + 1e-6f); a = a * rs; b = b * rs;
      const int h = col / 192, d = col - h * 192;
      if (d >= 128) rope8(a, b, rope + (size_t)tok_pos(row) * 32 + ((d - 128) >> 1));
      st_bf8(q + (size_t)row * 1536 + col, a, b); });
  }
};
struct EpiKV {
  static constexpr bool SPLIT = false;
  bf16_t* kb; bf16_t* vb;
  DI void operator()(const f32x4 (&acc)[2][2][4][2], const Unit& u, int wr, int wc, int fr, int fq) const {
    bf16_t* dst = u.pn < 4 ? kb : vb; const int cofs = u.pn < 4 ? 0 : 1024;
    pg8::epi_iter(acc, u, wr, wc, fr, fq, [&](int row, int col, f32x4 a, f32x4 b) { st_bf8(dst + (size_t)row * 1024 + (col - cofs), a, b); });
  }
};
struct EpiGate {
  static constexpr bool SPLIT = false;
  bf16_t* G;
  DI void operator()(const f32x4 (&acc)[2][2][4][2], const Unit& u, int wr, int wc, int fr, int fq) const {
    pg8::epi_iter(acc, u, wr, wc, fr, fq, [&](int row, int col, f32x4 a, f32x4 b) {
#pragma unroll
      for (int j = 0; j < 4; ++j) { a[j] = sigmoidf_(a[j]); b[j] = sigmoidf_(b[j]); }
      st_bf8(G + (size_t)row * 2048 + col, a, b); });
  }
};
DI void ld_bf8(const bf16_t* p, f32x4& a, f32x4& b) { const u32x4 w = *(const u32x4*)p; a = (f32x4){bflo(w.x), bfhi(w.x), bflo(w.y), bfhi(w.y)}; b = (f32x4){bflo(w.z), bfhi(w.z), bflo(w.w), bfhi(w.w)}; }
struct EpiMerged {
  static constexpr bool SPLIT = true;
  const bf16_t* G; bf16_t* merged;
  DI void mid(f32x4 (&acc)[2][2][4][2], const Unit& u, int wr, int wc, int fr, int fq) const {
    const int row0 = u.pm * 256 + wr * 64 + fr, col0 = u.pn * 256 + wc * 32 + 8 * fq;
#pragma unroll
    for (int ai = 0; ai < 2; ++ai)
#pragma unroll
      for (int m = 0; m < 4; ++m)
#pragma unroll
        for (int bj = 0; bj < 2; ++bj) {
          const bf16_t* gp = G + (size_t)(row0 + ai * 128 + m * 16) * 2048 + col0 + bj * 128;
          f32x4 a0, a1, b0, b1; ld_bf8(gp, a0, a1); ld_bf8(gp + 1024, b0, b1);
#pragma unroll
          for (int j = 0; j < 4; ++j) { acc[ai][bj][m][0][j] *= a0[j] * __builtin_amdgcn_rcpf(fmaxf(b0[j], 1e-30f)); acc[ai][bj][m][1][j] *= a1[j] * __builtin_amdgcn_rcpf(fmaxf(b1[j], 1e-30f)); }
        }
  }
  DI void operator()(const f32x4 (&acc)[2][2][4][2], const Unit& u, int wr, int wc, int fr, int fq) const {
    pg8::epi_iter(acc, u, wr, wc, fr, fq, [&](int row, int col, f32x4 a, f32x4 b) {
      f32x4 b0, b1; ld_bf8(G + (size_t)row * 2048 + 1024 + col, b0, b1);
      st_bf8(merged + (size_t)row * 1024 + col, a * b0, b * b1); });
  }
};
struct EpiOut {
  static constexpr bool SPLIT = false;
  const float* xp; const float* xs; float* h; bf16_t* hb; float* ssq;
  DI void operator()(const f32x4 (&acc)[2][2][4][2], const Unit& u, int wr, int wc, int fr, int fq) const {
    const int row0 = u.pm * 256 + wr * 64 + fr, col0 = u.pn * 256 + wc * 32 + 8 * fq;
#pragma unroll
    for (int ai = 0; ai < 2; ++ai)
#pragma unroll
      for (int m = 0; m < 4; ++m) {
        const int row = row0 + ai * 128 + m * 16;
        const float* x = (row < TP ? xp + (size_t)row * 1024 : xs + (size_t)(row - TP) * 1024);
        float sq = 0.f;
#pragma unroll
        for (int bj = 0; bj < 2; ++bj) { const int col = col0 + bj * 128;
          const f32x4 a = *(const f32x4*)(x + col) + acc[ai][bj][m][0], b = *(const f32x4*)(x + col + 4) + acc[ai][bj][m][1];
          float* o = h + (size_t)row * 1024 + col; *(f32x4*)o = a; *(f32x4*)(o + 4) = b;
          st_bf8(hb + (size_t)row * 1024 + col, a, b);
          sq += a[0] * a[0] + a[1] * a[1] + a[2] * a[2] + a[3] * a[3] + b[0] * b[0] + b[1] * b[1] + b[2] * b[2] + b[3] * b[3]; }
        sq += __shfl_xor(sq, 16); sq += __shfl_xor(sq, 32);
        if (fq == 0) atomicAdd(ssq + row, sq);
      }
  }
};
struct EpiUp {
  static constexpr bool SPLIT = false;
  bf16_t* up; float* out; const float* ssq;
  DI void operator()(const f32x4 (&acc)[2][2][4][2], const Unit& u, int wr, int wc, int fr, int fq) const {
    const int row0 = u.pm * 256 + wr * 64 + fr, col0 = u.pn * 256 + wc * 32 + 8 * fq;
#pragma unroll
    for (int ai = 0; ai < 2; ++ai)
#pragma unroll
      for (int m = 0; m < 4; ++m) {
        const int row = row0 + ai * 128 + m * 16;
        const float rs = rsqrtf(ssq[row] * (1.f / 1024.f) + 1e-6f);
        float* co = nullptr;
        if (row < TP) { const int s_ = row & (SEQ - 1); if (s_ >= SEQ - 2) co = out + O_CONVP + ((size_t)(row >> 14) * 2 + (s_ - (SEQ - 2))) * DFF2; }
        else { const int ts = row - TP, s_ = ts & 63; if (s_ >= 62) co = out + O_CONVS + ((size_t)(ts >> 6) * 2 + (s_ - 62)) * DFF2; }
#pragma unroll
        for (int bj = 0; bj < 2; ++bj) { const int col = col0 + bj * 128;
          const f32x4 a = acc[ai][bj][m][0] * rs, b = acc[ai][bj][m][1] * rs;
          st_bf8(up + (size_t)row * DFF2 + col, a, b);
          if (co) { *(f32x4*)(co + col) = a; *(f32x4*)(co + col + 4) = b; } }
      }
  }
};
struct EpiDownTail {
  static constexpr bool SPLIT = false;
  float* y; float* T; unsigned* flag;
  DI void operator()(const f32x4 (&acc)[2][2][4][2], const Unit& u, int wr, int wc, int fr, int fq) const {
    if (u.kofs == 0) {
      pg8::epi_iter(acc, u, wr, wc, fr, fq, [&](int row, int col, f32x4 a, f32x4 b) {
        float* o = y + (size_t)row * 1024 + col; *(f32x4*)o = *(const f32x4*)o + a; *(f32x4*)(o + 4) = *(const f32x4*)(o + 4) + b; });
    } else {
      pg8::epi_iter(acc, u, wr, wc, fr, fq, [&](int row, int col, f32x4 a, f32x4 b) {
        float* o = T + (size_t)row * 1024 + col; *(f32x4*)o = a; *(f32x4*)(o + 4) = b; });
      if (threadIdx.x == 0) flag[u.pm * 4 + u.pn] = 1u;
    }
  }
};
struct EpiDown {
  static constexpr bool SPLIT = false;
  float* y;
  DI void operator()(const f32x4 (&acc)[2][2][4][2], const Unit& u, int wr, int wc, int fr, int fq) const {
    pg8::epi_iter(acc, u, wr, wc, fr, fq, [&](int row, int col, f32x4 a, f32x4 b) {
      float* o = y + (size_t)row * 1024 + col;
      *(f32x4*)o = *(const f32x4*)o + a; *(f32x4*)(o + 4) = *(const f32x4*)(o + 4) + b; });
  }
};

namespace att {
constexpr int KVBLK = 64;
constexpr float SCALE = 0.07216878364870322f;
constexpr float THR = 8.f;
constexpr int LDQ = 1536, LDK = 1024, LDO = 1024;
constexpr int SHM_V = 64 * 128 * 2, SHM_K = 64 * 384;
#define KSWZ(row, colB) ((row) * 384 + ((colB) ^ ((((row) >> 1) & 7) << 4)))
#define SBAR() __builtin_amdgcn_sched_barrier(0)
DI int crow(int r, int hi) { return (r & 3) + 8 * (r >> 2) + 4 * hi; }
DI void partialSM(f32x16& p0, f32x16& p1, float& m_reg, float& mn, float& alpha) {
  constexpr float C = SCALE * 1.4426950408889634f;
  float pmax = p0[0];
#pragma unroll
  for (int r = 1; r < 16; ++r) pmax = fmaxf(pmax, p0[r]);
#pragma unroll
  for (int r = 0; r < 16; ++r) pmax = fmaxf(pmax, p1[r]);
  { auto rr = __builtin_amdgcn_permlane32_swap(__float_as_uint(pmax), __float_as_uint(pmax), false, false);
    pmax = fmaxf(__uint_as_float(rr[0]), __uint_as_float(rr[1])); }
  if (__builtin_expect(__all(pmax - m_reg <= THR / SCALE), 1)) { mn = m_reg; alpha = 1.f; }
  else { mn = fmaxf(m_reg, pmax); alpha = __builtin_amdgcn_exp2f((m_reg - mn) * C); m_reg = mn; }
  const float mnC = -mn * C;
#pragma unroll
  for (int r = 0; r < 16; ++r) p0[r] = fmaf(p0[r], C, mnC);
#pragma unroll
  for (int r = 0; r < 16; ++r) p1[r] = fmaf(p1[r], C, mnC);
#pragma unroll
  for (int r = 0; r < 16; ++r) p0[r] = __builtin_amdgcn_exp2f(p0[r]);
}
DI void finishSM(f32x16& p0, f32x16& p1, float alpha, float& l_reg, bf16x8& pa0, bf16x8& pa1, bf16x8& pa2, bf16x8& pa3) {
#pragma unroll
  for (int r = 0; r < 16; ++r) p1[r] = __builtin_amdgcn_exp2f(p1[r]);
  float ps = 0;
#pragma unroll
  for (int r = 0; r < 16; ++r) ps += p0[r];
#pragma unroll
  for (int r = 0; r < 16; ++r) ps += p1[r];
  { auto rr = __builtin_amdgcn_permlane32_swap(__float_as_uint(ps), __float_as_uint(ps), false, false);
    ps = __uint_as_float(rr[0]) + __uint_as_float(rr[1]); }
  l_reg = l_reg * alpha + ps;
#define PK4(P, BASE, OUT) do { unsigned a0 = cvt_pk(P[BASE + 0], P[BASE + 1]), a1 = cvt_pk(P[BASE + 2], P[BASE + 3]);   \
    unsigned b0 = cvt_pk(P[BASE + 4], P[BASE + 5]), b1 = cvt_pk(P[BASE + 6], P[BASE + 7]);                              \
    auto r0 = __builtin_amdgcn_permlane32_swap(a0, b0, false, false); auto r1 = __builtin_amdgcn_permlane32_swap(a1, b1, false, false); \
    u32x4 w = {r0[0], r1[0], r0[1], r1[1]}; OUT = *reinterpret_cast<bf16x8*>(&w); } while (0)
  PK4(p0, 0, pa0); PK4(p0, 8, pa1); PK4(p1, 0, pa2); PK4(p1, 8, pa3);
#undef PK4
}
template <int OFF> DI bf16x8 lds_rd128(int addr) { bf16x8 r; asm volatile("ds_read_b128 %0, %1 offset:%2" : "=&v"(r) : "v"(addr), "i"(OFF) : "memory"); return r; }
#define QK_RD(S, D0) do { ka[S] = lds_rd128<((D0) >> 2) * 128>(kb[(D0) & 3]); kc[S] = lds_rd128<((D0) >> 2) * 128 + 12288>(kb[(D0) & 3]); } while (0)
#define QK_STEP(D0, S, WAITN) do { asm volatile("s_waitcnt lgkmcnt(" #WAITN ")" ::: "memory"); SBAR(); \
    p0 = __builtin_amdgcn_mfma_f32_32x32x16_bf16(ka[S], qr[D0], p0, 0, 0, 0); p1 = __builtin_amdgcn_mfma_f32_32x32x16_bf16(kc[S], qr[D0], p1, 0, 0, 0); SBAR(); } while (0)
DI void qkt(f32x16& p0, f32x16& p1, const int (&kb)[4], const bf16x8* qr) {
  p0 = f32x16{}; p1 = f32x16{};
  bf16x8 ka[5], kc[5];
  QK_RD(0, 0); QK_RD(1, 1); QK_RD(2, 2); QK_RD(3, 3); QK_RD(4, 4);
  QK_STEP(0, 0, 8); QK_RD(0, 5);
  QK_STEP(1, 1, 8); QK_RD(1, 6);
  QK_STEP(2, 2, 8); QK_RD(2, 7);
  QK_STEP(3, 3, 8); QK_RD(3, 8);
  QK_STEP(4, 4, 8); QK_RD(4, 9);
  QK_STEP(5, 0, 8); QK_RD(0, 10);
  QK_STEP(6, 1, 8); QK_RD(1, 11);
  QK_STEP(7, 2, 8);
  QK_STEP(8, 3, 6);
  QK_STEP(9, 4, 4);
  QK_STEP(10, 0, 2);
  QK_STEP(11, 1, 0);
}
#undef QK_RD
#undef QK_STEP
DI int v_st(int k, int c) { const int kk = (k & ~0xC) | ((k & 4) << 1) | ((k & 8) >> 1); return ((kk >> 3) * 4 + (c >> 5)) * 512 + ((kk & 7) * 32 + (c & 31)) * 2; }
DI int v_rd_base(int lane) { return ((lane & 3) << 3) | (((lane >> 2) & 3) << 6) | (((lane >> 4) & 1) << 5) | (((lane >> 5) & 1) << 8); }
constexpr int v_rd_off(int d0, int ks, int half) { return d0 * 512 + ks * 4096 + half * 2048; }
template <int OFF> DI s16x4 tr_read(int vb) {
  s16x4 r; asm volatile("ds_read_b64_tr_b16 %0, %1 offset:%2" : "=&v"(r) : "v"(vb), "i"(OFF) : "memory"); return r;
}
#define PK(L, H) (bf16x8){L[0], L[1], L[2], L[3], H[0], H[1], H[2], H[3]}
#define PV_RD(SET, D0, KS) do { rl[SET][0] = tr_read<v_rd_off(D0, KS, 0)>(vb); rh[SET][0] = tr_read<v_rd_off(D0, KS, 1)>(vb); \
    rl[SET][1] = tr_read<v_rd_off(D0, (KS) + 1, 0)>(vb); rh[SET][1] = tr_read<v_rd_off(D0, (KS) + 1, 1)>(vb); } while (0)
#define PV_MM(SET, D0, PA, PB, WAITN) do { asm volatile("s_waitcnt lgkmcnt(" #WAITN ")" ::: "memory"); SBAR(); \
    o[D0] = __builtin_amdgcn_mfma_f32_32x32x16_bf16(PA, PK(rl[SET][0], rh[SET][0]), o[D0], 0, 0, 0); \
    o[D0] = __builtin_amdgcn_mfma_f32_32x32x16_bf16(PB, PK(rl[SET][1], rh[SET][1]), o[D0], 0, 0, 0); SBAR(); } while (0)
DI void pv_d0(f32x16* o, int vb, bf16x8 pa0, bf16x8 pa1, bf16x8 pa2, bf16x8 pa3) {
  s16x4 rl[3][2], rh[3][2];
  PV_RD(0, 0, 0); PV_RD(1, 0, 2);
  PV_RD(2, 1, 0); PV_MM(0, 0, pa0, pa1, 8);
  PV_RD(0, 1, 2); PV_MM(1, 0, pa2, pa3, 8);
  PV_RD(1, 2, 0); PV_MM(2, 1, pa0, pa1, 8);
  PV_RD(2, 2, 2); PV_MM(0, 1, pa2, pa3, 8);
  PV_RD(0, 3, 0); PV_MM(1, 2, pa0, pa1, 8);
  PV_RD(1, 3, 2); PV_MM(2, 2, pa2, pa3, 8);
  PV_MM(0, 3, pa0, pa1, 4);
  PV_MM(1, 3, pa2, pa3, 0);
}
#undef PV_RD
#undef PV_MM
#undef PK

DI void attn_body(const bf16_t* __restrict__ Qw, const bf16_t* __restrict__ Kh, const bf16_t* __restrict__ Vh, const bf16_t* __restrict__ Kr,
                  bf16_t* __restrict__ Ow, int NT, int kvis, bool act, unsigned char* lds) {
  const int tid = get_tid(), wid = tid >> 6, lane = tid & 63, r32 = lane & 31, hi = lane >> 5;
  unsigned char* V_lds = lds; unsigned char* K_lds = lds + 3 * SHM_V;
  float* wsl = (float*)(lds + 3 * SHM_V + 2 * SHM_K) + wid * 64; float* li_l = wsl; float* al_l = wsl + 32;
  float m_reg = -1e30f, l_reg = 0; f32x16 o[4] = {}; bf16x8 qr[12];
  const bf16_t* Ql = Qw + (size_t)r32 * LDQ + hi * 8;
#pragma unroll
  for (int d0 = 0; d0 < 12; ++d0) qr[d0] = *reinterpret_cast<const bf16x8*>(Ql + d0 * 16);
  const int vb0 = (int)(uintptr_t)(LAS unsigned char*)V_lds + v_rd_base(lane);
  const int wu = __builtin_amdgcn_readfirstlane(wid);
  int koff[3], voff[2];
#pragma unroll
  for (int i = 0; i < 3; ++i) { const int L = 1024 * (wu * 3 + i) + 16 * lane, row = L / 384, cs = (L - row * 384) >> 4, c16 = cs ^ ((row >> 1) & 7);
    koff[i] = c16 < 16 ? row * 1024 + c16 * 8 : (int)(0x80000000u | (unsigned)(row * 64 + (c16 - 16) * 8)); }
#pragma unroll
  for (int i = 0; i < 2; ++i) { const int L = 1024 * (wu * 2 + i) + 16 * lane, sub = L >> 9, within = (L & 511) >> 1, kk = (sub >> 2) * 8 + (within >> 5), cl = within & 31;
    const int k = (kk & ~0xC) | ((kk & 4) << 1) | ((kk & 8) >> 1); voff[i] = k * 1024 + (sub & 3) * 32 + cl; }
  LAS unsigned char* Kd = (LAS unsigned char*)K_lds + wu * 3072; LAS unsigned char* Vd = (LAS unsigned char*)V_lds + wu * 2048;
#define SLOAD(k0, kbuf, vbuf) do { \
    _Pragma("unroll") for (int _i = 0; _i < 3; ++_i) { const bf16_t* _s = koff[_i] < 0 ? Kr + (size_t)(k0) * 64 + (koff[_i] & 0x7fffffff) : Kh + (size_t)(k0) * LDK + koff[_i]; \
      __builtin_amdgcn_global_load_lds((const unsigned*)_s, (LAS unsigned*)(Kd + (kbuf) * SHM_K + _i * 1024), 16, 0, 0); } \
    _Pragma("unroll") for (int _i = 0; _i < 2; ++_i) { const bf16_t* _s = Vh + (size_t)(k0) * LDK + voff[_i]; \
      __builtin_amdgcn_global_load_lds((const unsigned*)_s, (LAS unsigned*)(Vd + (vbuf) * SHM_V + _i * 1024), 16, 0, 0); } } while (0)
#define SWAIT() asm volatile("s_waitcnt vmcnt(0)" ::: "memory")
#define RESC(a) do { if (__any((a) < 1.f)) { if (hi == 0) al_l[r32] = (a); asm volatile("s_waitcnt lgkmcnt(0)" ::: "memory"); \
    _Pragma("unroll") for (int d = 0; d < 4; ++d) _Pragma("unroll") for (int r = 0; r < 16; ++r) o[d][r] *= al_l[crow(r, hi)]; } } while (0)
#define MASKP(P0, P1, tile) do { if (__builtin_expect((tile) >= kvis_u, 0)) { _Pragma("unroll") for (int r = 0; r < 16; ++r) { P0[r] = -1e30f; P1[r] = -1e30f; } } } while (0)
  const int kvis_u = __builtin_amdgcn_readfirstlane(kvis);
  f32x16 p0, p1; float mn, al = 1.f; bf16x8 pa0, pa1, pa2, pa3;
  int kbr[4];
  { const int f = (r32 >> 1) & 7;
#pragma unroll
    for (int q = 0; q < 4; ++q) kbr[q] = (int)(uintptr_t)(LAS unsigned char*)K_lds + r32 * 384 + ((((q << 1) | hi) ^ f) << 4); }
  SLOAD(0, 0, 0); SWAIT(); __syncthreads();
  for (int j = 0; j < NT; ++j) {
    const int bsel = j & 1;
    if (j + 1 < NT) SLOAD((j + 1) * KVBLK, bsel ^ 1, bsel ^ 1);
    SBAR();
    if (act && j < kvis_u) {
      int kb[4];
#pragma unroll
      for (int q = 0; q < 4; ++q) kb[q] = kbr[q] + bsel * SHM_K;
      qkt(p0, p1, kb, qr);
      partialSM(p0, p1, m_reg, mn, al);
      RESC(al);
      finishSM(p0, p1, al, l_reg, pa0, pa1, pa2, pa3); SBAR();
      pv_d0(o, vb0 + bsel * SHM_V, pa0, pa1, pa2, pa3);
    }
    SBAR();
    SWAIT();
    __syncthreads();
  }
  if (act) {
    if (hi == 0) li_l[r32] = l_reg;
    asm volatile("s_waitcnt lgkmcnt(0)" ::: "memory");
    float rli[16];
#pragma unroll
    for (int r = 0; r < 16; ++r) rli[r] = __builtin_amdgcn_rcpf(li_l[crow(r, hi)]);
#pragma unroll
    for (int r = 0; r < 16; ++r) { const int orow = crow(r, hi);
#pragma unroll
      for (int d0 = 0; d0 < 4; ++d0) Ow[(size_t)orow * LDO + d0 * 32 + r32] = f2bf(o[d0][r] * rli[r]); }
  }
#undef SLOAD
#undef SWAIT
#undef RESC
#undef MASKP
}
}

#define XB_XCNT(j) (64 * (j))
#define XB_XSUB(j) (1024 + 64 * (j))
#define XB_XGEN(j) (2048 + 64 * (j))
#define XB_TOP 3072
#define XB_TOPGEN 3136
DI unsigned xb_ld(unsigned* p) { return __hip_atomic_load(p, __ATOMIC_RELAXED, __HIP_MEMORY_SCOPE_AGENT); }
DI unsigned xb_add(unsigned* p, unsigned v) { return __hip_atomic_fetch_add(p, v, __ATOMIC_RELAXED, __HIP_MEMORY_SCOPE_AGENT); }
DI void xb_st(unsigned* p, unsigned v) { __hip_atomic_store(p, v, __ATOMIC_RELAXED, __HIP_MEMORY_SCOPE_AGENT); }
DI unsigned xb_xcc_id() { return (unsigned)__builtin_amdgcn_s_getreg((3 << 11) | 20) & 0xFu; }
struct GBar { unsigned* bar; unsigned x, nloc, nx, k; };
#define XB_SPINW(cond) do { unsigned _sp = 0; while (cond) { __builtin_amdgcn_s_sleep(1); if (++_sp > (1u << 22)) break; } } while (0)
DI void gbar(GBar& g) {
  asm volatile("s_waitcnt vmcnt(0)" ::: "memory");
  __syncthreads();
  g.k += 1;
  if (threadIdx.x == 0) {
    const unsigned k = g.k;
    const unsigned prev = xb_add(&g.bar[XB_XSUB(g.x)], 1u);
    if (prev + 1u == g.nloc * k) {
      __builtin_amdgcn_fence(__ATOMIC_RELEASE, "agent");
      asm volatile("s_waitcnt vmcnt(0)" ::: "memory");
      const unsigned pt = xb_add(&g.bar[XB_TOP], 1u);
      if (pt + 1u == g.nx * k) {
#pragma unroll
        for (int j = 0; j < 16; ++j) xb_st(&g.bar[XB_XGEN(j)], k);
      } else XB_SPINW(xb_ld(&g.bar[XB_XGEN(g.x)]) < k);
    } else XB_SPINW(xb_ld(&g.bar[XB_XGEN(g.x)]) < k);
    __builtin_amdgcn_fence(__ATOMIC_ACQUIRE, "agent");
    asm volatile("s_waitcnt vmcnt(0)" ::: "memory");
  }
  __syncthreads();
}

DI int colmap(int mode, int n, int coloff) {
  if (mode == 0) return n + coloff;
  if (mode == 1) { if (n < 3072) return n; if (n < 3136) { const int p = n - 3072; return 3072 + (p & 1) * 32 + (p >> 1); } return -1; }
  const int h = n / 192, d = n - h * 192; if (d < 128) return n; const int p = d - 128; return h * 192 + 128 + (p & 1) * 32 + (p >> 1);
}
DI void transpose_tile(const float* __restrict__ src, int ld, int K, int k0, int n0, int mode, int coloff, bf16_t* __restrict__ dst, float* tl, const float* __restrict__ kscale) {
  const int tid = get_tid();
  const bool plain = mode == 0 || (mode == 1 && n0 + 64 <= 3072) || (mode == 2 && (n0 % 192) != 128);
  if (plain) {
    const int kk = tid >> 4, n4 = (tid & 15) * 4;
#pragma unroll
    for (int i = 0; i < 2; ++i) { const int k = kk + 32 * i; f32x4 w = *(const f32x4*)(src + (size_t)(k0 + k) * ld + coloff + n0 + n4);
      if (kscale) w = w * kscale[k0 + k];
      tl[k * 65 + n4] = w[0]; tl[k * 65 + n4 + 1] = w[1]; tl[k * 65 + n4 + 2] = w[2]; tl[k * 65 + n4 + 3] = w[3]; }
    __syncthreads();
    const int n = tid >> 3, kc = (tid & 7) * 8;
    f32x4 a, b;
#pragma unroll
    for (int i = 0; i < 4; ++i) { a[i] = tl[(kc + i) * 65 + n]; b[i] = tl[(kc + 4 + i) * 65 + n]; }
    st_bf8(dst + (size_t)(n0 + n) * K + k0 + kc, a, b);
    __syncthreads();
    return;
  }
  const int tx = tid & 63, ty = tid >> 6;
  const int sc = colmap(mode, n0 + tx, coloff);
#pragma unroll
  for (int i = 0; i < 8; ++i) { const int k = ty * 8 + i; const float w = sc >= 0 ? src[(size_t)(k0 + k) * ld + sc] : 0.f; tl[k * 65 + tx] = kscale ? w * kscale[k0 + k] : w; }
  __syncthreads();
#pragma unroll
  for (int i = 0; i < 8; ++i) { const int nn = ty * 8 + i; dst[(size_t)(n0 + nn) * K + k0 + tx] = f2bf(tl[tx * 65 + nn]); }
  __syncthreads();
}
DI void phase0(const Params& p, unsigned char* shm) {
  const int tid = get_tid(), wid = tid >> 6, lane = tid & 63, nblk = gridDim.x, bid = get_bid();
  if (bid == 0 && tid < 64) ((unsigned*)(p.ws + OFF_CNT))[tid] = 0u;
  if (tid == 0) xb_add((unsigned*)(p.ws + OFF_BAR) + XB_XCNT(xb_xcc_id()), 1u);
  float* tl = (float*)shm;
  for (int it = bid; it < 4672; it += nblk) {
    const float* src; const float* ksc = nullptr; int ld, K, ktiles, mode = 0, coloff = 0, base; size_t doff;
    if (it < 832) { src = p.in[6]; ld = INC; K = 1024; mode = 1; base = 0; doff = OFF_WIN; }
    else if (it < 1344) { src = p.in[6]; ld = INC; K = 1024; coloff = OFFG; base = 832; doff = OFF_WG; }
    else if (it < 1536) { src = p.in[12]; ld = 1536; K = 512; mode = 2; base = 1344; doff = OFF_WUQ; ksc = p.in[11]; }
    else if (it < 1664) { src = p.in[14]; ld = 1024; K = 512; base = 1536; doff = OFF_WKV; }
    else if (it < 1792) { src = p.in[15]; ld = 1024; K = 512; base = 1664; doff = OFF_WKV + (size_t)1024 * 512 * 2; }
    else if (it < 2048) { src = p.in[16]; ld = 1024; K = 1024; base = 1792; doff = OFF_WPA; }
    else if (it < 2304) { src = p.in[17]; ld = 1024; K = 1024; base = 2048; doff = OFF_WPB; }
    else if (it < 2560) { src = p.in[18]; ld = 1024; K = 1024; base = 2304; doff = OFF_WOUT; }
    else if (it < 3968) { src = p.in[20]; ld = DFF2; K = 1024; base = 2560; doff = OFF_WUP; ksc = p.in[19]; }
    else { src = p.in[23]; ld = 1024; K = DFF; base = 3968; doff = OFF_WDN; }
    ktiles = K / 64;
    const int li = it - base, kt = li % ktiles, ntile = li / ktiles;
    transpose_tile(src, ld, K, kt * 64, ntile * 64, mode, coloff, (bf16_t*)(p.ws + doff), tl, ksc);
  }
  const int gw = bid * 8 + wid, nw = nblk * 8;
  { const float* g = p.in[5]; bf16_t* xn = (bf16_t*)(p.ws + OFF_XN);
    f32x4 gv[4];
#pragma unroll
    for (int i = 0; i < 4; ++i) gv[i] = *(const f32x4*)(g + lane * 4 + i * 256);
    for (int t = gw; t < TT; t += 2 * nw) {
      const int t2 = t + nw; const bool has2 = t2 < TT;
      const float* x = xrow(p, t); const float* x2 = xrow(p, has2 ? t2 : t); f32x4 v[4], w[4]; float ss = 0, ss2 = 0;
#pragma unroll
      for (int i = 0; i < 4; ++i) { v[i] = *(const f32x4*)(x + lane * 4 + i * 256); w[i] = *(const f32x4*)(x2 + lane * 4 + i * 256); }
#pragma unroll
      for (int i = 0; i < 4; ++i) { ss += v[i][0] * v[i][0] + v[i][1] * v[i][1] + v[i][2] * v[i][2] + v[i][3] * v[i][3]; ss2 += w[i][0] * w[i][0] + w[i][1] * w[i][1] + w[i][2] * w[i][2] + w[i][3] * w[i][3]; }
      ss = wave_sum(ss); ss2 = wave_sum(ss2);
      const float rs = rsqrtf(ss * (1.f / 1024.f) + 1e-6f), rs2 = rsqrtf(ss2 * (1.f / 1024.f) + 1e-6f);
#pragma unroll
      for (int i = 0; i < 4; ++i) { u32x2 o; o.x = cvt_pk(v[i][0] * rs * gv[i][0], v[i][1] * rs * gv[i][1]); o.y = cvt_pk(v[i][2] * rs * gv[i][2], v[i][3] * rs * gv[i][3]);
        *(u32x2*)(xn + (size_t)t * 1024 + lane * 4 + i * 256) = o;
        if (has2) { u32x2 o2; o2.x = cvt_pk(w[i][0] * rs2 * gv[i][0], w[i][1] * rs2 * gv[i][1]); o2.y = cvt_pk(w[i][2] * rs2 * gv[i][2], w[i][3] * rs2 * gv[i][3]);
          *(u32x2*)(xn + (size_t)t2 * 1024 + lane * 4 + i * 256) = o2; } }
    } }
  { const float* c = p.in[2]; bf16_t* ca = (bf16_t*)(p.ws + OFF_CKV);
    const int total = NBS * KVS * 64;
#pragma unroll 4
    for (int i = bid * 512 + tid; i < total; i += nblk * 512) {
      const int r = i >> 6, l8 = (i & 63) * 8; const int b = r / KVS, s = r - b * KVS;
      bf16_t* d = ca + ((size_t)TP + r) * 512 + l8;
      if (s < PAST) { const float* x = c + ((size_t)b * PAST + s) * 512 + l8; st_bf8(d, *(const f32x4*)x, *(const f32x4*)(x + 4)); }
      else if (s >= PAST + 64) { *(u32x4*)d = (u32x4){0u, 0u, 0u, 0u}; }
    } }
  { const float* c = p.in[3]; bf16_t* ka = (bf16_t*)((unsigned char*)p.out + OB_KR);
    const int total = NBS * KVS * 8;
#pragma unroll 2
    for (int i = bid * 512 + tid; i < total; i += nblk * 512) {
      const int r = i >> 3, o8 = (i & 7) * 8; const int b = r / KVS, s = r - b * KVS;
      bf16_t* d = ka + ((size_t)TP + r) * 64 + o8;
      if (s < PAST) { const float* x = c + ((size_t)b * PAST + s) * 64 + (o8 >> 1); const f32x4 lo = *(const f32x4*)x, hi4 = *(const f32x4*)(x + 32);
        st_bf8(d, (f32x4){lo[0], hi4[0], lo[1], hi4[1]}, (f32x4){lo[2], hi4[2], lo[3], hi4[3]}); }
      else if (s >= PAST + 64) { *(u32x4*)d = (u32x4){0u, 0u, 0u, 0u}; }
    } }
  { float* sq = (float*)(p.ws + OFF_SSQ); for (int i = bid * 512 + tid; i < TT; i += nblk * 512) sq[i] = 0.f; }
  { float* st = (float*)(p.ws + OFF_STAT); for (int i = bid * 512 + tid; i < 3 * TT; i += nblk * 512) st[i] = 0.f; }
  if (bid == 1) { unsigned* tf = (unsigned*)(p.ws + OFF_TFLAG); for (int i = tid; i < 1024; i += 512) tf[i] = 0u; }
  { float2* tb = (float2*)(p.ws + OFF_ROPE);
    for (int i = bid * 512 + tid; i < 16384 * 32; i += nblk * 512) {
      const int pos = i >> 5, k = i & 31;
      const double inv = exp(-(double)k * (9.210340371976184 / 32.0));
      const double ang = (double)pos * inv;
      tb[i] = make_float2((float)cos(ang), (float)sin(ang));
    } }
  { const float* w = p.in[9]; bf16_t* wb = (bf16_t*)(p.ws + OFF_WSB);
    for (int i = bid * 512 + tid; i < 8 * 128 * 128; i += nblk * 512) { const int t = (i >> 7) & 127, s = i & 127; wb[i] = s <= t ? f2bf(w[i]) : (bf16_t)0; } }
}

DI void phase2(const Params& p) {
  const int tid = get_tid(), wid = tid >> 6, lane = tid & 63, nblk = gridDim.x, bid = get_bid();
  const int gw = bid * 8 + wid, nw = nblk * 8;
  bf16_t* ca = (bf16_t*)(p.ws + OFF_CKV); const float* kg = p.in[13];
  const f32x4 g0 = *(const f32x4*)(kg + lane * 8), g1 = *(const f32x4*)(kg + lane * 8 + 4);
  for (int t = gw; t < TT; t += 2 * nw) {
    const int t2 = t + nw; const bool has2 = t2 < TT;
    float* r0 = ckv_out(p.out, t) + lane * 8; float* r1 = ckv_out(p.out, has2 ? t2 : t) + lane * 8;
    f32x4 a0 = *(const f32x4*)r0, a1 = *(const f32x4*)(r0 + 4), c0 = *(const f32x4*)r1, c1 = *(const f32x4*)(r1 + 4);
    float ss = a0[0] * a0[0] + a0[1] * a0[1] + a0[2] * a0[2] + a0[3] * a0[3] + a1[0] * a1[0] + a1[1] * a1[1] + a1[2] * a1[2] + a1[3] * a1[3];
    float s2 = c0[0] * c0[0] + c0[1] * c0[1] + c0[2] * c0[2] + c0[3] * c0[3] + c1[0] * c1[0] + c1[1] * c1[1] + c1[2] * c1[2] + c1[3] * c1[3];
    ss = wave_sum(ss); s2 = wave_sum(s2);
    const float rs = rsqrtf(ss * (1.f / 512.f) + 1e-6f), rs2 = rsqrtf(s2 * (1.f / 512.f) + 1e-6f);
    a0 = a0 * rs * g0; a1 = a1 * rs * g1;
    *(f32x4*)r0 = a0; *(f32x4*)(r0 + 4) = a1;
    st_bf8(ca + (size_t)tok_kvrow(t) * 512 + lane * 8, a0, a1);
    if (has2) { c0 = c0 * rs2 * g0; c1 = c1 * rs2 * g1;
      *(f32x4*)r1 = c0; *(f32x4*)(r1 + 4) = c1;
      st_bf8(ca + (size_t)tok_kvrow(t2) * 512 + lane * 8, c0, c1); }
  }
}

DI void spatial_phase(const Params& p, unsigned char* shm) {
  const int tid = get_tid(), wid = tid >> 6, lane = tid & 63, r32 = lane & 31, hi = lane >> 5, nblk = gridDim.x, bid = get_bid();
  const bf16_t* v = (const bf16_t*)(p.ws + OFF_V); bf16_t* ua = (bf16_t*)(p.ws + OFF_UA); const bf16_t* wsb = (const bf16_t*)(p.ws + OFF_WSB);
  const float* bs = p.in[10]; const float* lng = p.in[7]; const float* lnb = p.in[8]; const float* vstat = (const float*)(p.ws + OFF_STAT);
  const int sr = tid >> 4, sc = (tid & 15) * 8, vst0 = att::v_st(sr, sc), vst1 = att::v_st(32 + sr, sc);
  const int vbase = (int)(uintptr_t)(LAS unsigned char*)shm + att::v_rd_base(lane);
  const int gsel = wid >> 2, tb = wid & 3;
  for (int it = bid; it < (256 + 32) * 4; it += nblk) {
    const int ch = it >> 2, gp = it & 3;
    int row0, nrows;
    if (ch < 256) { row0 = ch * 128; nrows = 128; } else { row0 = TP + (ch - 256) * 64; nrows = 64; }
    __syncthreads();
#pragma unroll
    for (int gs = 0; gs < 2; ++gs)
#pragma unroll
      for (int sh = 0; sh < 2; ++sh) {
        if (sh * 64 < nrows) {
          const int c0 = (gp * 2 + gs) * 128 + sc;
          const f32x4 g0 = *(const f32x4*)(lng + c0), g1 = *(const f32x4*)(lng + c0 + 4), b0 = *(const f32x4*)(lnb + c0), b1 = *(const f32x4*)(lnb + c0 + 4);
          unsigned char* d = shm + (gs * 2 + sh) * 16384;
#pragma unroll
          for (int rr_ = 0; rr_ < 2; ++rr_) {
            const int r = row0 + sh * 64 + sr + 32 * rr_;
            const u32x4 w = *(const u32x4*)(v + (size_t)r * 1024 + c0);
            const float mean = vstat[r] * (1.f / 1024.f), var = fmaxf(vstat[TT + r] * (1.f / 1024.f) - mean * mean, 0.f), rs = rsqrtf(var + 1e-6f);
            f32x4 x0 = {bflo(w.x), bfhi(w.x), bflo(w.y), bfhi(w.y)}, x1 = {bflo(w.z), bfhi(w.z), bflo(w.w), bfhi(w.w)};
            x0 = (x0 - mean) * rs * g0 + b0; x1 = (x1 - mean) * rs * g1 + b1;
            u32x4 o_; o_.x = cvt_pk(x0[0], x0[1]); o_.y = cvt_pk(x0[2], x0[3]); o_.z = cvt_pk(x1[0], x1[1]); o_.w = cvt_pk(x1[2], x1[3]);
            *(u32x4*)(d + (rr_ ? vst1 : vst0)) = o_;
            if (r >= TP) { float* go = p.out + O_GV + (size_t)(r - TP) * 1024 + c0; *(f32x4*)go = x0; *(f32x4*)(go + 4) = x1; }
          }
        } }
    __syncthreads();
    if (tb * 32 < nrows) {
      const int g = gp * 2 + gsel;
      f32x16 o[4] = {};
      const int nsh = tb >= 2 ? 2 : 1;
      for (int sh = 0; sh < nsh; ++sh) {
        const bf16_t* wrow = wsb + ((size_t)g * 128 + tb * 32 + r32) * 128 + sh * 64 + hi * 8;
        const bf16x8 pa0 = *(const bf16x8*)(wrow), pa1 = *(const bf16x8*)(wrow + 16), pa2 = *(const bf16x8*)(wrow + 32), pa3 = *(const bf16x8*)(wrow + 48);
        att::pv_d0(o, vbase + (gsel * 2 + sh) * 16384, pa0, pa1, pa2, pa3);
      }
#pragma unroll
      for (int r = 0; r < 16; ++r) { const int t = tb * 32 + att::crow(r, hi); const float bb = bs[g * 128 + t];
#pragma unroll
        for (int d0 = 0; d0 < 4; ++d0) { bf16_t* e = ua + (size_t)(row0 + t) * 1024 + g * 128 + d0 * 32 + r32; *e = f2bf(bf2f(*e) * (o[d0][r] + bb)); } }
    }
  }
  __syncthreads();
}

DI void attn_phase(const Params& p, unsigned char* shm, int ci = 0) {
  const int tid = get_tid(), wid = tid >> 6;
  unsigned* cnt = (unsigned*)(p.ws + OFF_CNT) + ci;
  volatile int* s_item = (volatile int*)(shm + 3 * att::SHM_V + 2 * att::SHM_K + 8 * 64 * 4);
  const bf16_t* q = (const bf16_t*)((unsigned char*)p.out + OB_Q); const bf16_t* kr = (const bf16_t*)((unsigned char*)p.out + OB_KR);
  const bf16_t* kb = (const bf16_t*)(p.ws + OFF_KB); const bf16_t* vb = (const bf16_t*)(p.ws + OFF_VB); bf16_t* ao = (bf16_t*)(p.ws + OFF_ATTN);
  for (;;) {
    __syncthreads();
    if (tid == 0) *s_item = (int)atomicAdd(cnt, 1u);
    __syncthreads();
    const int it = *s_item;
    if (it >= 1280) break;
    if (it < 256) {
      const int b = it >> 3, h = it & 7; const size_t kv0 = (size_t)TP + (size_t)b * KVS; const size_t q0 = (size_t)TP + b * 64 + (wid & 1) * 32;
      att::attn_body(q + q0 * 1536 + h * 192, kb + kv0 * 1024 + h * 128, vb + kv0 * 1024 + h * 128, kr + kv0 * 64,
                     ao + q0 * 1024 + h * 128, 66, 65, wid < 2, shm);
    } else {
      const int i = it - 256, qb = 63 - (i >> 4), bh = i & 15, b = bh >> 3, h = bh & 7;
      const size_t kv0 = (size_t)b * SEQ; const size_t q0 = kv0 + qb * 256 + wid * 32;
      att::attn_body(q + q0 * 1536 + h * 192, kb + kv0 * 1024 + h * 128, vb + kv0 * 1024 + h * 128, kr + kv0 * 64,
                     ao + q0 * 1024 + h * 128, 4 * qb + 4, 4 * qb + (wid >> 1) + 1, true, shm);
    }
  }
}

DI void rmsnorm_rows(const Params& p, float* src, const float* g, bf16_t* dst, const float* T, const unsigned* tflag) {
  const int tid = get_tid(), wid = tid >> 6, lane = tid & 63, gw = get_bid() * 8 + wid, nw = gridDim.x * 8;
  f32x4 gv[4];
#pragma unroll
  for (int i = 0; i < 4; ++i) gv[i] = *(const f32x4*)(g + lane * 4 + i * 256);
  for (int t = gw; t < TT; t += 2 * nw) {
    const int t2 = t + nw; const bool has2 = t2 < TT;
    float* x = src + (size_t)t * 1024; float* x2 = src + (size_t)(has2 ? t2 : t) * 1024;
    f32x4 v[4], w[4]; float ss = 0, ss2 = 0;
#pragma unroll
    for (int i = 0; i < 4; ++i) { v[i] = *(const f32x4*)(x + lane * 4 + i * 256); w[i] = *(const f32x4*)(x2 + lane * 4 + i * 256);
      if (T) { if (tflag[(t >> 8) * 4 + i]) v[i] += *(const f32x4*)(T + (size_t)t * 1024 + lane * 4 + i * 256);
               if (has2 && tflag[(t2 >> 8) * 4 + i]) w[i] += *(const f32x4*)(T + (size_t)t2 * 1024 + lane * 4 + i * 256); } }
#pragma unroll
    for (int i = 0; i < 4; ++i) { ss += v[i][0] * v[i][0] + v[i][1] * v[i][1] + v[i][2] * v[i][2] + v[i][3] * v[i][3]; ss2 += w[i][0] * w[i][0] + w[i][1] * w[i][1] + w[i][2] * w[i][2] + w[i][3] * w[i][3]; }
    ss = wave_sum(ss); ss2 = wave_sum(ss2);
    const float rs = rsqrtf(ss * (1.f / 1024.f) + 1e-6f), rs2 = rsqrtf(ss2 * (1.f / 1024.f) + 1e-6f);
#pragma unroll
    for (int i = 0; i < 4; ++i) {
      const f32x4 y = v[i] * rs * gv[i], y2 = w[i] * rs2 * gv[i];
      if (dst) { u32x2 o; o.x = cvt_pk(y[0], y[1]); o.y = cvt_pk(y[2], y[3]); *(u32x2*)(dst + (size_t)t * 1024 + lane * 4 + i * 256) = o;
        if (has2) { u32x2 o2; o2.x = cvt_pk(y2[0], y2[1]); o2.y = cvt_pk(y2[2], y2[3]); *(u32x2*)(dst + (size_t)t2 * 1024 + lane * 4 + i * 256) = o2; } }
      else { __builtin_nontemporal_store(y, (f32x4*)(x + lane * 4 + i * 256)); if (has2) __builtin_nontemporal_store(y2, (f32x4*)(x2 + lane * 4 + i * 256)); }
    }
  }
}

DI void unpack8(const u32x4 w, float (&o)[8]) { o[0] = bflo(w.x); o[1] = bfhi(w.x); o[2] = bflo(w.y); o[3] = bfhi(w.y); o[4] = bflo(w.z); o[5] = bfhi(w.z); o[6] = bflo(w.w); o[7] = bfhi(w.w); }
DI void convgate_phase(const Params& p) {
  const bf16_t* up = (const bf16_t*)(p.ws + OFF_UP); bf16_t* act = (bf16_t*)(p.ws + OFF_ACT);
  const float* cw = p.in[21]; const float* cb = p.in[22];
  const int tid = get_tid(), wid = tid >> 6, lane = tid & 63, gw = get_bid() * 8 + wid, nw = gridDim.x * 8;
  const int nper = nw / 6;
  const int slab = gw % 6, idx = gw / 6;
  const int j8 = (slab * 64 + lane) * 8;
  if (idx >= nper || j8 >= DFF) return;
  float wv[3][8], wg[3][8], bv[8], bg[8];
#pragma unroll
  for (int k = 0; k < 3; ++k) { const f32x4 a = *(const f32x4*)(cw + k * DFF2 + j8), b = *(const f32x4*)(cw + k * DFF2 + j8 + 4), c = *(const f32x4*)(cw + k * DFF2 + DFF + j8), d = *(const f32x4*)(cw + k * DFF2 + DFF + j8 + 4);
#pragma unroll
    for (int j = 0; j < 4; ++j) { wv[k][j] = a[j]; wv[k][4 + j] = b[j]; wg[k][j] = c[j]; wg[k][4 + j] = d[j]; } }
  { const f32x4 a = *(const f32x4*)(cb + j8), b = *(const f32x4*)(cb + j8 + 4), c = *(const f32x4*)(cb + DFF + j8), d = *(const f32x4*)(cb + DFF + j8 + 4);
#pragma unroll
    for (int j = 0; j < 4; ++j) { bv[j] = a[j]; bv[4 + j] = b[j]; bg[j] = c[j]; bg[4 + j] = d[j]; } }
  for (int seg = idx; seg < TT / 8; seg += nper) {
    const int t0 = seg * 8;
    int s0, b; const bool pr = t0 < TP;
    if (pr) { s0 = t0 & (SEQ - 1); b = 0; } else { s0 = (t0 - TP) & 63; b = (t0 - TP) >> 6; }
    u32x4 rv[8], rg[8];
#pragma unroll
    for (int r = 0; r < 8; ++r) { rv[r] = *(const u32x4*)(up + (size_t)(t0 + r) * DFF2 + j8); rg[r] = *(const u32x4*)(up + (size_t)(t0 + r) * DFF2 + DFF + j8); }
    float v2[8], v1[8], g2[8], g1[8];
    if (s0 != 0) {
      unpack8(*(const u32x4*)(up + (size_t)(t0 - 2) * DFF2 + j8), v2); unpack8(*(const u32x4*)(up + (size_t)(t0 - 1) * DFF2 + j8), v1);
      unpack8(*(const u32x4*)(up + (size_t)(t0 - 2) * DFF2 + DFF + j8), g2); unpack8(*(const u32x4*)(up + (size_t)(t0 - 1) * DFF2 + DFF + j8), g1);
    } else if (pr) {
#pragma unroll
      for (int j = 0; j < 8; ++j) { v2[j] = 0.f; v1[j] = 0.f; g2[j] = 0.f; g1[j] = 0.f; }
    } else {
      const float* st = p.in[4] + (size_t)b * 2 * DFF2 + j8;
#pragma unroll
      for (int j = 0; j < 8; ++j) { v2[j] = st[j]; v1[j] = st[DFF2 + j]; g2[j] = st[DFF + j]; g1[j] = st[DFF2 + DFF + j]; }
    }
#pragma unroll
    for (int r = 0; r < 8; ++r) {
      float v0[8], g0[8]; unpack8(rv[r], v0); unpack8(rg[r], g0);
      f32x4 y0, y1;
#pragma unroll
      for (int j = 0; j < 8; ++j) {
        const float cv = bv[j] + v2[j] * wv[0][j] + v1[j] * wv[1][j] + v0[j] * wv[2][j];
        const float cg_ = bg[j] + g2[j] * wg[0][j] + g1[j] * wg[1][j] + g0[j] * wg[2][j];
        const float y = cg_ * sigmoidf_(cg_) * cv;
        if (j < 4) y0[j] = y; else y1[j - 4] = y;
        v2[j] = v1[j]; v1[j] = v0[j]; g2[j] = g1[j]; g1[j] = g0[j];
      }
      st_bf8(act + (size_t)(t0 + r) * DFF + j8, y0, y1);
    }
  }
}


__global__ void __launch_bounds__(512, 2) mega(Params p) {
  extern __shared__ __attribute__((aligned(16))) unsigned char shm[];
  cg::grid_group grid = cg::this_grid();
  LAS unsigned char* lds = (LAS unsigned char*)shm;
  const int nblk = gridDim.x, bid = get_bid();
  unsigned char* ws = p.ws;
  pg8::StaticOrder S;
  GBar gb; gb.bar = (unsigned*)(ws + OFF_BAR); gb.x = xb_xcc_id(); gb.k = 0;

#ifndef PMASK
#define PMASK 0xffff
#endif
#ifndef PROBE_DUP
#define PROBE_DUP -1
#endif
#define PM(b) for (int _r = 0; _r < ((b) == PROBE_DUP ? 2 : 1); ++_r)
  PM(0) phase0(p, shm);
  grid.sync();
  { unsigned nx = 0; for (int j = 0; j < 16; ++j) nx += xb_ld(&gb.bar[XB_XCNT(j)]) != 0u; gb.nx = nx; gb.nloc = xb_ld(&gb.bar[XB_XCNT(gb.x)]); }
  PM(1) { pg8::Gemm g{(const bf16_t*)(ws + OFF_XN), (const bf16_t*)(ws + OFF_WIN), 1024, 1024, TT, NZ, 1024, nullptr, nullptr, 0}; S.init(TT, NZ, nblk, bid);
    EpiZ e{(bf16_t*)(ws + OFF_UA), (bf16_t*)(ws + OFF_V), (bf16_t*)(ws + OFF_QLAT), p.out, (bf16_t*)((unsigned char*)p.out + OB_KR), (const float2*)(ws + OFF_ROPE), (float*)(ws + OFF_STAT)};
    pg8::gemm_phase(lds, g, S, e); }
  gbar(gb);
  PM(2) phase2(p);
  PM(3) spatial_phase(p, shm);
  PM(4) { pg8::Gemm g{(const bf16_t*)(ws + OFF_QLAT), (const bf16_t*)(ws + OFF_WUQ), 512, 512, TT, 1536, 512, nullptr, nullptr, 0}; S.init(TT, 1536, nblk, bid);
    EpiQ e{(bf16_t*)((unsigned char*)p.out + OB_Q), (const float2*)(ws + OFF_ROPE), (const float*)(ws + OFF_STAT) + 2 * TT};
    pg8::gemm_phase(lds, g, S, e); }
  gbar(gb);
  PM(5) { pg8::Gemm g{(const bf16_t*)(ws + OFF_CKV), (const bf16_t*)(ws + OFF_WKV), 512, 512, RALL, 2048, 512, nullptr, nullptr, 0}; S.init(RALL, 2048, nblk, bid);
    EpiKV e{(bf16_t*)(ws + OFF_KB), (bf16_t*)(ws + OFF_VB)};
    pg8::gemm_phase(lds, g, S, e); }
  gbar(gb);
  PM(6) attn_phase(p, shm);
#ifdef PROBE_ATTN2
  gbar(gb);
  attn_phase(p, shm, 1);
#endif
  gbar(gb);
  PM(7) { bf16_t* G = (bf16_t*)(ws + OFF_T1); bf16_t* mg = (bf16_t*)(ws + OFF_MERGED);
    { pg8::Gemm g{(const bf16_t*)(ws + OFF_XN), (const bf16_t*)(ws + OFF_WG), 1024, 1024, TT, 2048, 1024, nullptr, nullptr, 0}; S.init(TT, 2048, nblk, bid); EpiGate e{G}; pg8::gemm_phase(lds, g, S, e); }
    gbar(gb);
    { pg8::Gemm g{(const bf16_t*)(ws + OFF_UA), (const bf16_t*)(ws + OFF_WPA), 1024, 1024, TT, 1024, 2048, (const bf16_t*)(ws + OFF_ATTN), (const bf16_t*)(ws + OFF_WPB), 16}; S.init(TT, 1024, nblk, bid);
      EpiMerged e{G, mg}; pg8::gemm_phase(lds, g, S, e); } }
  gbar(gb);
  PM(8) { pg8::Gemm g{(const bf16_t*)(ws + OFF_MERGED), (const bf16_t*)(ws + OFF_WOUT), 1024, 1024, TT, 1024, 1024, nullptr, nullptr, 0}; S.init(TT, 1024, nblk, bid);
    EpiOut e{p.in[0], p.in[1], p.out + O_Y, (bf16_t*)(ws + OFF_HN), (float*)(ws + OFF_SSQ)}; pg8::gemm_phase(lds, g, S, e); }
  gbar(gb);
  PM(10) { pg8::Gemm g{(const bf16_t*)(ws + OFF_HN), (const bf16_t*)(ws + OFF_WUP), 1024, 1024, TT, DFF2, 1024, nullptr, nullptr, 0}; S.init(TT, DFF2, nblk, bid);
    EpiUp e{(bf16_t*)(ws + OFF_UP), p.out, (const float*)(ws + OFF_SSQ)}; pg8::gemm_phase(lds, g, S, e); }
  gbar(gb);
  PM(11) convgate_phase(p);
  gbar(gb);
  PM(12) { pg8::Gemm g{(const bf16_t*)(ws + OFF_ACT), (const bf16_t*)(ws + OFF_WDN), DFF, DFF, TT, 1024, DFF, nullptr, nullptr, 0}; S.init(TT, 1024, nblk, bid);
    S.lim = 512; EpiDown e{p.out + O_Y}; pg8::gemm_phase(lds, g, S, e);
    pg8::Gemm g2{(const bf16_t*)(ws + OFF_ACT), (const bf16_t*)(ws + OFF_WDN), DFF, DFF, TT, 1024, DFF / 2, nullptr, nullptr, 0};
    S.tail = DFF / 2; EpiDownTail e2{p.out + O_Y, (float*)(ws + OFF_TPART), (unsigned*)(ws + OFF_TFLAG)}; pg8::gemm_phase(lds, g2, S, e2); }
  gbar(gb);
#ifdef PROBE_SYNC
  for (int i = 0; i < 12; ++i) gbar(gb);
#endif
  PM(13) rmsnorm_rows(p, p.out + O_Y, p.in[24], nullptr, (const float*)(ws + OFF_TPART), (const unsigned*)(ws + OFF_TFLAG));
}

constexpr int DYN_LDS = 131072 + 4096;

extern "C" void kernel_launch(void* const* d_in, const int* in_sizes, int n_in, void* d_out, int out_size, void* d_ws, size_t ws_size, hipStream_t stream) {
  static int grid_blocks = 0;
  if (!grid_blocks) {
    if (n_in != 25 || (size_t)out_size != O_END || ws_size < WS_END) { fprintf(stderr, "kernel_launch: unexpected shapes (n_in %d out %d ws %zu need %zu)\n", n_in, out_size, ws_size, WS_END); return; }
    if (hipFuncSetAttribute((const void*)mega, hipFuncAttributeMaxDynamicSharedMemorySize, DYN_LDS) != hipSuccess) { fprintf(stderr, "kernel_launch: LDS attribute failed\n"); return; }
    int dev = 0, cus = 0, per_cu = 0;
    hipGetDevice(&dev);
    hipDeviceGetAttribute(&cus, hipDeviceAttributeMultiprocessorCount, dev);
    hipOccupancyMaxActiveBlocksPerMultiprocessor(&per_cu, mega, 512, DYN_LDS);
    if (per_cu < 1 || cus < 1) { fprintf(stderr, "kernel_launch: occupancy query gave %d blocks/CU on %d CUs\n", per_cu, cus); return; }
    grid_blocks = cus;
  }
  Params p{};
  for (int i = 0; i < 25; ++i) p.in[i] = (const float*)d_in[i];
  p.out = (float*)d_out; p.ws = (unsigned char*)d_ws;
  hipMemsetAsync((unsigned char*)d_ws + OFF_BAR, 0, BAR_BYTES, stream);
  void* args[] = {&p};
  hipError_t e = hipLaunchCooperativeKernel((const void*)mega, dim3(grid_blocks), dim3(512), args, DYN_LDS, stream);
  if (e != hipSuccess) fprintf(stderr, "cooperative launch failed: %s (grid %d)\n", hipGetErrorString(e), grid_blocks);
}
```

```cpp
#include <hip/hip_runtime.h>
#include <hip/hip_cooperative_groups.h>
#include <cstdio>
#include <cstdint>
namespace cg = cooperative_groups;

typedef unsigned short bf16_t;
typedef short bf16x8 __attribute__((ext_vector_type(8)));
typedef short s16x4 __attribute__((ext_vector_type(4)));
typedef float f32x4 __attribute__((ext_vector_type(4)));
typedef float f32x16 __attribute__((ext_vector_type(16)));
typedef unsigned u32x4 __attribute__((ext_vector_type(4)));
typedef unsigned u32x2 __attribute__((ext_vector_type(2)));
#define LAS __attribute__((address_space(3)))
#define DI __device__ __forceinline__

constexpr int TP = 32768, TS = 2048, TT = TP + TS;
constexpr int SEQ = 16384, PAST = 4096, NBS = 32;
constexpr int KVS = 4224;
constexpr int RALL = TP + NBS * KVS;
constexpr int NZ = 3328;
constexpr int DFF = 2816, DFF2 = 5632;
constexpr int OFFG = 3136;
constexpr int INC = 5184;

constexpr size_t OFF_WIN = 0;
constexpr size_t OFF_WG = OFF_WIN + (size_t)NZ * 1024 * 2;
constexpr size_t OFF_WUQ = OFF_WG + (size_t)2048 * 1024 * 2;
constexpr size_t OFF_WKV = OFF_WUQ + (size_t)1536 * 512 * 2;
constexpr size_t OFF_WPA = OFF_WKV + (size_t)2048 * 512 * 2;
constexpr size_t OFF_WPB = OFF_WPA + (size_t)1024 * 1024 * 2;
constexpr size_t OFF_WOUT = OFF_WPB + (size_t)1024 * 1024 * 2;
constexpr size_t OFF_WUP = OFF_WOUT + (size_t)1024 * 1024 * 2;
constexpr size_t OFF_WDN = OFF_WUP + (size_t)DFF2 * 1024 * 2;
constexpr size_t OFF_WSB = OFF_WDN + (size_t)1024 * DFF * 2;
constexpr size_t OFF_ROPE = OFF_WSB + (size_t)8 * 128 * 128 * 2;
constexpr size_t OFF_CNT = OFF_ROPE + (size_t)16384 * 32 * 8;
constexpr size_t OFF_XN = OFF_CNT + 256;
constexpr size_t OFF_UA = OFF_XN + (size_t)TT * 1024 * 2;
constexpr size_t OFF_CKV = OFF_UA + (size_t)TT * 1024 * 2;
constexpr size_t OFF_KB = OFF_CKV + (size_t)RALL * 512 * 2;
constexpr size_t OFF_VB = OFF_KB + (size_t)RALL * 1024 * 2;
constexpr size_t OFF_BAR = OFF_VB + (size_t)RALL * 1024 * 2;
constexpr size_t BAR_BYTES = 16384;
constexpr size_t OFF_SSQ = OFF_BAR + BAR_BYTES;
constexpr size_t OFF_TFLAG = OFF_SSQ + (size_t)TT * 4;
constexpr size_t OFF_STAT = OFF_TFLAG + 4096;
constexpr size_t WS_END = OFF_STAT + (size_t)3 * TT * 4;
constexpr size_t OFF_TPART = OFF_CKV;
constexpr size_t OFF_ATTN = OFF_CKV;
constexpr size_t OFF_V = OFF_KB;
constexpr size_t OFF_QLAT = OFF_KB + (size_t)TT * 1024 * 2;
constexpr size_t OFF_T1 = OFF_KB;
constexpr size_t OFF_T2 = OFF_KB + (size_t)TT * 1024 * 4;
constexpr size_t OFF_MERGED = OFF_VB;
constexpr size_t OFF_HN = OFF_XN;
constexpr size_t OFF_UP = OFF_KB;
constexpr size_t OFF_ACT = OFF_KB + (size_t)400 * 1024 * 1024;
static_assert(WS_END <= ((size_t)1 << 30), "workspace map exceeds 1 GiB");
static_assert((size_t)TT * 1024 * 4 <= (size_t)RALL * 512 * 2, "T does not fit the ckv region");
static_assert(OFF_T2 + (size_t)TT * 1024 * 4 <= OFF_VB, "T2 overlaps merged");
static_assert((size_t)TT * DFF2 * 2 <= (size_t)400 * 1024 * 1024, "up overlaps act");
static_assert(OFF_ACT + (size_t)TT * DFF * 2 <= WS_END, "act out of range");

constexpr size_t O_Y = 0, O_CKVP = 35651584, O_KRP = 52428800, O_CONVP = 54525952, O_CKVS = 54548480, O_KRS = 55597056,
                 O_CONVS = 55728128, O_GV = 56088576, O_END = 58185728;
constexpr size_t OB_Q = 0, OB_KR = (size_t)TT * 1536 * 2;
static_assert(OB_KR + (size_t)RALL * 64 * 2 <= (size_t)TP * 1024 * 4, "d_out scratch too large");

struct Params { const float* in[25]; float* out; unsigned char* ws; };

DI int get_tid() { int t = threadIdx.x; asm volatile("" : "+v"(t)); return t; }
DI int get_bid() { int b = blockIdx.x; asm volatile("" : "+s"(b)); return b; }
typedef __bf16 bf16x2_t __attribute__((ext_vector_type(2)));
typedef float f32x2_t __attribute__((ext_vector_type(2)));
DI unsigned cvt_pk(float lo, float hi) { const f32x2_t v = {lo, hi}; const bf16x2_t r = __builtin_convertvector(v, bf16x2_t); return __builtin_bit_cast(unsigned, r); }
DI float bf2f(unsigned short b) { return __uint_as_float(((unsigned)b) << 16); }
DI bf16_t f2bf(float f) { return (bf16_t)(cvt_pk(f, 0.f) & 0xffffu); }
DI float bflo(unsigned w) { return __uint_as_float(w << 16); }
DI float bfhi(unsigned w) { return __uint_as_float(w & 0xffff0000u); }
DI void st_bf8(bf16_t* p, f32x4 a, f32x4 b) { u32x4 w; w.x = cvt_pk(a[0], a[1]); w.y = cvt_pk(a[2], a[3]); w.z = cvt_pk(b[0], b[1]); w.w = cvt_pk(b[2], b[3]); *(u32x4*)p = w; }
DI float wave_sum(float v) {
#pragma unroll
  for (int o = 32; o; o >>= 1) v += __shfl_xor(v, o);
  return v;
}
DI float sigmoidf_(float x) { return __builtin_amdgcn_rcpf(1.f + __builtin_amdgcn_exp2f(-1.4426950408889634f * x)); }
DI float gelu_tanh(float x) { const float y = 1.5957691216057308f * (x + 0.044715f * x * x * x); return x * sigmoidf_(y); }
DI const float* xrow(const Params& p, int t) { return t < TP ? p.in[0] + (size_t)t * 1024 : p.in[1] + (size_t)(t - TP) * 1024; }
DI int tok_pos(int t) { return t < TP ? (t & (SEQ - 1)) : PAST + ((t - TP) & 63); }
DI int tok_kvrow(int t) { if (t < TP) return t; const int ts = t - TP; return TP + (ts >> 6) * KVS + PAST + (ts & 63); }
DI float* ckv_out(float* out, int t) { return t < TP ? out + O_CKVP + (size_t)t * 512 : out + O_CKVS + (size_t)(t - TP) * 512; }
DI float* kr_out(float* out, int t) { return t < TP ? out + O_KRP + (size_t)t * 64 : out + O_KRS + (size_t)(t - TP) * 64; }

namespace pg8 {
constexpr int BM = 256, BK = 64, HALF = 128, HTB = HALF * BK * 2, STAGE_BYTES = 8 * HTB, NXCD = 8, WGM = 8;
DI int lds_byte(int r, int c) { const int st = (r >> 4) * 2 + (c >> 5), rr = r & 15, cc = c & 31, ob = rr * 64 + cc * 2; return st * 1024 + (ob ^ (((ob >> 9) & 1) << 5)); }
DI void stage_rc(int b, int& R, int& C) { const int st = b / 1024, sb = b % 1024, swz = sb ^ (((sb >> 9) & 1) << 5); R = (st >> 1) * 16 + swz / 64; C = (st & 1) * 32 + (swz % 64) / 2; }
DI int perm32(int rho) { const int n = rho >> 4, i = rho & 15; return 8 * (i >> 2) + 4 * n + (i & 3); }
struct Unit { int pm, pn, kofs; };
struct Gemm { const bf16_t* A; const bf16_t* Bt; int lda, ldb, M, N, K; const bf16_t* A2; const bf16_t* Bt2; int ns; };
struct StaticOrder {
  int nM, nN, nwg, G, c;
  int lim, tail;
  DI void init(int M, int N, int G_, int c_) { nM = M / BM; nN = N / BM; nwg = nM * nN; G = G_; c = c_; lim = nwg; tail = 0; }
  DI bool next(int i, Unit& u) const {
    long L = (long)i * G + c; u.kofs = 0;
    if (tail) { if (i > 0 || (c >> 1) >= nwg - lim) return false; L = lim + (c >> 1); u.kofs = (c & 1) * tail; }
    else if (L >= lim) return false;
    int wgid = (int)L; { const int q = nwg / NXCD, r = nwg % NXCD, xcd = wgid % NXCD, off = wgid / NXCD; wgid = (xcd < r ? xcd * (q + 1) : r * (q + 1) + (xcd - r) * q) + off; }
    const int nig = WGM * nN, gid = wgid / nig, fm = gid * WGM, gsz = (nM - fm) < WGM ? (nM - fm) : WGM;
    u.pm = fm + ((wgid % nig) % gsz); u.pn = (wgid % nig) / gsz; return true;
  }
};
template <class Epi>
DI void gemm_phase(LAS unsigned char* lds, const Gemm g, const StaticOrder& S, const Epi& E) {
  const int tid = get_tid(), wid = __builtin_amdgcn_readfirstlane(tid >> 6), lane = tid & 63, wr = wid >> 2, wc = wid & 3, fr = lane & 15, fq = lane >> 4;
  const int K = g.K, nt = K / BK;
  unsigned voffA[2], voffB[2];
#pragma unroll
  for (int i = 0; i < 2; ++i) { int R, C; stage_rc(tid * 16 + i * 8192, R, C); const int Rb = (R & ~31) + perm32(R & 31);
    voffA[i] = (unsigned)(R * g.lda + C) * 2u; voffB[i] = (unsigned)(Rb * g.ldb + C) * 2u; }
  const size_t kstep = (size_t)(BK * 2);
  const size_t hstepA = (size_t)HALF * g.lda * 2, hstepB = (size_t)HALF * g.ldb * 2;
  const size_t tstepA = 2 * hstepA, tstepB = 2 * hstepB;
  const unsigned ldsw = (unsigned)wid * 1024u;
  const int aoff = lds_byte(wr * 64 + fr, fq * 8), boff = lds_byte(wc * 32 + fr, fq * 8);
#define PG8_SA(b, h) (((b) * 2 + (h)) * HTB)
#define PG8_SB(b, h) ((4 + (b) * 2 + (h)) * HTB)
#define PG8_STAGE(bufoff, gbase, voff) do { _Pragma("unroll") for (int _i = 0; _i < 2; ++_i) \
    __builtin_amdgcn_global_load_lds((const unsigned*)((const char*)(gbase) + (voff)[_i]), (LAS unsigned*)(lds + (bufoff) + ldsw + _i * 8192), 16, 0, 0); } while (0)
#define PG8_LDA(dst, b, h) do { _Pragma("unroll") for (int m = 0; m < 4; ++m) _Pragma("unroll") for (int k = 0; k < 2; ++k) dst[m][k] = *(const LAS bf16x8*)(lds + PG8_SA(b, h) + aoff + m * 2048 + k * 1024); } while (0)
#define PG8_LDB(dst, b, h) do { _Pragma("unroll") for (int n = 0; n < 2; ++n) _Pragma("unroll") for (int k = 0; k < 2; ++k) dst[n][k] = *(const LAS bf16x8*)(lds + PG8_SB(b, h) + boff + n * 2048 + k * 1024); } while (0)
#define PG8_MMA(ai, bj, At, Bt) do { __builtin_amdgcn_s_setprio(1); _Pragma("unroll") for (int m = 0; m < 4; ++m) _Pragma("unroll") for (int n = 0; n < 2; ++n) _Pragma("unroll") for (int k = 0; k < 2; ++k) \
    acc[ai][bj][m][n] = __builtin_amdgcn_mfma_f32_16x16x32_bf16(Bt[n][k], At[m][k], acc[ai][bj][m][n], 0, 0, 0); __builtin_amdgcn_s_setprio(0); } while (0)
#define PG8_WAIT_V(n) asm volatile("s_waitcnt vmcnt(" #n ")" ::: "memory")
#define PG8_WAIT_L(n) asm volatile("s_waitcnt lgkmcnt(" #n ")" ::: "memory")
#define PG8_BAR __builtin_amdgcn_s_barrier()
#define PG8_SCHED __builtin_amdgcn_sched_barrier(0)
  Unit cur, nxt; int ui = 0;
  if (!S.next(0, cur)) return;
  f32x4 acc[2][2][4][2];
#pragma unroll
  for (int a = 0; a < 2; ++a)
#pragma unroll
    for (int b = 0; b < 2; ++b)
#pragma unroll
      for (int m = 0; m < 4; ++m)
#pragma unroll
        for (int n = 0; n < 2; ++n) acc[a][b][m][n] = (f32x4){0.f, 0.f, 0.f, 0.f};
  bf16x8 At[4][2], B0[2][2], B1[2][2];
  const char* cA = (const char*)g.A + (size_t)cur.pm * tstepA + (size_t)cur.kofs * 2; const char* cB = (const char*)g.Bt + (size_t)cur.pn * tstepB + (size_t)cur.kofs * 2;
  const int ns = Epi::SPLIT ? g.ns : nt;
  PG8_STAGE(PG8_SB(0, 0), cB, voffB); PG8_STAGE(PG8_SA(0, 0), cA, voffA); PG8_STAGE(PG8_SB(0, 1), cB + hstepB, voffB); PG8_STAGE(PG8_SA(0, 1), cA + hstepA, voffA);
  if (wr == 1) PG8_BAR;
  PG8_WAIT_V(4); PG8_BAR;
  PG8_STAGE(PG8_SB(1, 0), cB + kstep, voffB); PG8_STAGE(PG8_SA(1, 0), cA + kstep, voffA); PG8_STAGE(PG8_SB(1, 1), cB + hstepB + kstep, voffB);
  PG8_WAIT_V(6); PG8_BAR;
  for (;;) {
    const bool has_next = S.next(ui + 1, nxt);
    const char* nA = has_next ? (const char*)g.A + (size_t)nxt.pm * tstepA + (size_t)nxt.kofs * 2 : cA; const char* nB = has_next ? (const char*)g.Bt + (size_t)nxt.pn * tstepB + (size_t)nxt.kofs * 2 : cB;
    for (int t = 0; t < nt; t += 2) {
      const bool last = (t == nt - 2);
      const char* a1 = (Epi::SPLIT && t >= ns) ? (const char*)g.A2 + (size_t)cur.pm * tstepA + (size_t)(t + 1 - ns) * kstep : cA + (size_t)(t + 1) * kstep;
      const char* a2; const char* b2;
      if (last) { a2 = nA; b2 = nB; }
      else if (Epi::SPLIT && t + 2 >= ns) { a2 = (const char*)g.A2 + (size_t)cur.pm * tstepA + (size_t)(t + 2 - ns) * kstep; b2 = (const char*)g.Bt2 + (size_t)cur.pn * tstepB + (size_t)(t + 2 - ns) * kstep; }
      else { a2 = cA + (size_t)(t + 2) * kstep; b2 = cB + (size_t)(t + 2) * kstep; }
      if constexpr (Epi::SPLIT) { if (t == ns) E.mid(acc, cur, wr, wc, fr, fq); }
      const char* a3 = a2 + kstep; const char* b3 = b2 + kstep;
      PG8_LDB(B0, 0, 0); PG8_SCHED; PG8_LDA(At, 0, 0); PG8_STAGE(PG8_SA(1, 1), a1 + hstepA, voffA);
      PG8_WAIT_L(8); PG8_BAR; PG8_WAIT_L(0); PG8_MMA(0, 0, At, B0); PG8_BAR; PG8_SCHED;
      PG8_LDB(B1, 0, 1); PG8_STAGE(PG8_SB(0, 0), b2, voffB);
      PG8_BAR; PG8_WAIT_L(0); PG8_MMA(0, 1, At, B1); PG8_BAR;
      PG8_LDA(At, 0, 1); PG8_STAGE(PG8_SA(0, 0), a2, voffA);
      PG8_BAR; PG8_WAIT_L(0); PG8_MMA(1, 0, At, B0); PG8_BAR; PG8_SCHED;
      PG8_STAGE(PG8_SB(0, 1), b2 + hstepB, voffB);
      PG8_WAIT_V(6); PG8_BAR; PG8_MMA(1, 1, At, B1); PG8_BAR;
      PG8_LDB(B0, 1, 0); PG8_SCHED; PG8_LDA(At, 1, 0); PG8_STAGE(PG8_SA(0, 1), a2 + hstepA, voffA);
      PG8_WAIT_L(8); PG8_BAR; PG8_WAIT_L(0); PG8_MMA(0, 0, At, B0); PG8_BAR; PG8_SCHED;
      PG8_LDB(B1, 1, 1); PG8_STAGE(PG8_SB(1, 0), b3, voffB);
      PG8_BAR; PG8_WAIT_L(0); PG8_MMA(0, 1, At, B1); PG8_BAR;
      PG8_LDA(At, 1, 1); PG8_STAGE(PG8_SA(1, 0), a3, voffA);
      PG8_BAR; PG8_WAIT_L(0); PG8_MMA(1, 0, At, B0); PG8_BAR; PG8_SCHED;
      PG8_STAGE(PG8_SB(1, 1), b3 + hstepB, voffB);
      PG8_WAIT_V(6); PG8_BAR; PG8_MMA(1, 1, At, B1); PG8_BAR;
    }
    E(acc, cur, wr, wc, fr, fq);
    if (!has_next) break;
#pragma unroll
    for (int a = 0; a < 2; ++a)
#pragma unroll
      for (int b = 0; b < 2; ++b)
#pragma unroll
        for (int m = 0; m < 4; ++m)
#pragma unroll
          for (int n = 0; n < 2; ++n) acc[a][b][m][n] = (f32x4){0.f, 0.f, 0.f, 0.f};
    cur = nxt; cA = nA; cB = nB; ++ui;
  }
  PG8_WAIT_V(0);
  if (wr == 0) PG8_BAR;
  PG8_BAR;
#undef PG8_SA
#undef PG8_SB
#undef PG8_STAGE
#undef PG8_LDA
#undef PG8_LDB
#undef PG8_MMA
#undef PG8_WAIT_V
#undef PG8_WAIT_L
#undef PG8_BAR
#undef PG8_SCHED
}
template <class F>
DI void epi_iter(const f32x4 (&acc)[2][2][4][2], const Unit& u, int wr, int wc, int fr, int fq, F&& f) {
  const int row0 = u.pm * BM + wr * 64 + fr, col0 = u.pn * BM + wc * 32 + 8 * fq;
#pragma unroll
  for (int ai = 0; ai < 2; ++ai)
#pragma unroll
    for (int m = 0; m < 4; ++m)
#pragma unroll
      for (int bj = 0; bj < 2; ++bj) f(row0 + ai * HALF + m * 16, col0 + bj * HALF, acc[ai][bj][m][0], acc[ai][bj][m][1]);
}
}
using pg8::Unit;

DI void rope8(f32x4& a, f32x4& b, const float2* cs) {
  const float2 c0 = cs[0], c1 = cs[1], c2 = cs[2], c3 = cs[3];
  f32x4 ra, rb;
  ra[0] = a[0] * c0.x - a[1] * c0.y; ra[1] = a[0] * c0.y + a[1] * c0.x;
  ra[2] = a[2] * c1.x - a[3] * c1.y; ra[3] = a[2] * c1.y + a[3] * c1.x;
  rb[0] = b[0] * c2.x - b[1] * c2.y; rb[1] = b[0] * c2.y + b[1] * c2.x;
  rb[2] = b[2] * c3.x - b[3] * c3.y; rb[3] = b[2] * c3.y + b[3] * c3.x;
  a = ra; b = rb;
}

struct EpiZ {
  static constexpr bool SPLIT = false;
  bf16_t* ua; bf16_t* v; bf16_t* qlat; float* out; bf16_t* krall; const float2* rope; float* stat;
  DI void operator()(const f32x4 (&acc)[2][2][4][2], const Unit& u, int wr, int wc, int fr, int fq) const {
    const int pn = u.pn;
    if (pn < 4) {
      pg8::epi_iter(acc, u, wr, wc, fr, fq, [&](int row, int col, f32x4 a, f32x4 b) {
#pragma unroll
        for (int j = 0; j < 4; ++j) { a[j] = gelu_tanh(a[j]); b[j] = gelu_tanh(b[j]); }
        st_bf8(ua + (size_t)row * 1024 + col, a, b); });
    } else if (pn < 10) {
      const bool isv = pn < 8;
      const int row0 = u.pm * 256 + wr * 64 + fr, col0 = u.pn * 256 + wc * 32 + 8 * fq;
#pragma unroll
      for (int ai = 0; ai < 2; ++ai)
#pragma unroll
        for (int m = 0; m < 4; ++m) {
          const int row = row0 + ai * 128 + m * 16; float s1 = 0.f, s2 = 0.f;
#pragma unroll
          for (int bj = 0; bj < 2; ++bj) { const int col = col0 + bj * 128; f32x4 a = acc[ai][bj][m][0], b = acc[ai][bj][m][1];
            if (isv) {
#pragma unroll
              for (int j = 0; j < 4; ++j) { a[j] = gelu_tanh(a[j]); b[j] = gelu_tanh(b[j]); }
              st_bf8(v + (size_t)row * 1024 + (col - 1024), a, b);
            } else st_bf8(qlat + (size_t)row * 512 + (col - 2048), a, b);
            s1 += a[0] + a[1] + a[2] + a[3] + b[0] + b[1] + b[2] + b[3];
            s2 += a[0] * a[0] + a[1] * a[1] + a[2] * a[2] + a[3] * a[3] + b[0] * b[0] + b[1] * b[1] + b[2] * b[2] + b[3] * b[3]; }
          s1 += __shfl_xor(s1, 16); s1 += __shfl_xor(s1, 32); s2 += __shfl_xor(s2, 16); s2 += __shfl_xor(s2, 32);
          if (fq == 0) { if (isv) { atomicAdd(stat + row, s1); atomicAdd(stat + TT + row, s2); } else atomicAdd(stat + 2 * TT + row, s2); }
        }
    } else if (pn < 12) {
      pg8::epi_iter(acc, u, wr, wc, fr, fq, [&](int row, int col, f32x4 a, f32x4 b) { float* o = ckv_out(out, row) + (col - 2560); *(f32x4*)o = a; *(f32x4*)(o + 4) = b; });
    } else {
      pg8::epi_iter(acc, u, wr, wc, fr, fq, [&](int row, int col, f32x4 a, f32x4 b) {
        const int pcol = col - 3072;
        if (pcol < 64) {
          const int i0 = pcol >> 1;
          rope8(a, b, rope + (size_t)tok_pos(row) * 32 + i0);
          float* ko = kr_out(out, row);
          ko[i0] = a[0]; ko[32 + i0] = a[1]; ko[i0 + 1] = a[2]; ko[33 + i0] = a[3];
          ko[i0 + 2] = b[0]; ko[34 + i0] = b[1]; ko[i0 + 3] = b[2]; ko[35 + i0] = b[3];
          st_bf8(krall + (size_t)tok_kvrow(row) * 64 + pcol, a, b);
        } });
    }
  }
};
struct EpiQ {
  static constexpr bool SPLIT = false;
  bf16_t* q; const float2* rope; const float* qsq;
  DI void operator()(const f32x4 (&acc)[2][2][4][2], const Unit& u, int wr, int wc, int fr, int fq) const {
    pg8::epi_iter(acc, u, wr, wc, fr, fq, [&](int row, int col, f32x4 a, f32x4 b) {
      const float rs = rsqrtf(qsq[row] * (1.f / 512.f) + 1e-6f); a = a * rs; b = b * rs;
      const int h = col / 192, d = col - h * 192;
      if (d >= 128) rope8(a, b, rope + (size_t)tok_pos(row) * 32 + ((d - 128) >> 1));
      st_bf8(q + (size_t)row * 1536 + col, a, b); });
  }
};
struct EpiKV {
  static constexpr bool SPLIT = false;
  bf16_t* kb; bf16_t* vb;
  DI void operator()(const f32x4 (&acc)[2][2][4][2], const Unit& u, int wr, int wc, int fr, int fq) const {
    bf16_t* dst = u.pn < 4 ? kb : vb; const int cofs = u.pn < 4 ? 0 : 1024;
    pg8::epi_iter(acc, u, wr, wc, fr, fq, [&](int row, int col, f32x4 a, f32x4 b) { st_bf8(dst + (size_t)row * 1024 + (col - cofs), a, b); });
  }
};
struct EpiGate {
  static constexpr bool SPLIT = false;
  bf16_t* G;
  DI void operator()(const f32x4 (&acc)[2][2][4][2], const Unit& u, int wr, int wc, int fr, int fq) const {
    pg8::epi_iter(acc, u, wr, wc, fr, fq, [&](int row, int col, f32x4 a, f32x4 b) {
#pragma unroll
      for (int j = 0; j < 4; ++j) { a[j] = sigmoidf_(a[j]); b[j] = sigmoidf_(b[j]); }
      st_bf8(G + (size_t)row * 2048 + col, a, b); });
  }
};
DI void ld_bf8(const bf16_t* p, f32x4& a, f32x4& b) { const u32x4 w = *(const u32x4*)p; a = (f32x4){bflo(w.x), bfhi(w.x), bflo(w.y), bfhi(w.y)}; b = (f32x4){bflo(w.z), bfhi(w.z), bflo(w.w), bfhi(w.w)}; }
struct EpiMerged {
  static constexpr bool SPLIT = true;
  const bf16_t* G; bf16_t* merged;
  DI void mid(f32x4 (&acc)[2][2][4][2], const Unit& u, int wr, int wc, int fr, int fq) const {
    const int row0 = u.pm * 256 + wr * 64 + fr, col0 = u.pn * 256 + wc * 32 + 8 * fq;
#pragma unroll
    for (int ai = 0; ai < 2; ++ai)
#pragma unroll
      for (int m = 0; m < 4; ++m)
#pragma unroll
        for (int bj = 0; bj < 2; ++bj) {
          const bf16_t* gp = G + (size_t)(row0 + ai * 128 + m * 16) * 2048 + col0 + bj * 128;
          f32x4 a0, a1, b0, b1; ld_bf8(gp, a0, a1); ld_bf8(gp + 1024, b0, b1);
#pragma unroll
          for (int j = 0; j < 4; ++j) { acc[ai][bj][m][0][j] *= a0[j] * __builtin_amdgcn_rcpf(fmaxf(b0[j], 1e-30f)); acc[ai][bj][m][1][j] *= a1[j] * __builtin_amdgcn_rcpf(fmaxf(b1[j], 1e-30f)); }
        }
  }
  DI void operator()(const f32x4 (&acc)[2][2][4][2], const Unit& u, int wr, int wc, int fr, int fq) const {
    pg8::epi_iter(acc, u, wr, wc, fr, fq, [&](int row, int col, f32x4 a, f32x4 b) {
      f32x4 b0, b1; ld_bf8(G + (size_t)row * 2048 + 1024 + col, b0, b1);
      st_bf8(merged + (size_t)row * 1024 + col, a * b0, b * b1); });
  }
};
struct EpiOut {
  static constexpr bool SPLIT = false;
  const float* xp; const float* xs; float* h; bf16_t* hb; float* ssq;
  DI void operator()(const f32x4 (&acc)[2][2][4][2], const Unit& u, int wr, int wc, int fr, int fq) const {
    const int row0 = u.pm * 256 + wr * 64 + fr, col0 = u.pn * 256 + wc * 32 + 8 * fq;
#pragma unroll
    for (int ai = 0; ai < 2; ++ai)
#pragma unroll
      for (int m = 0; m < 4; ++m) {
        const int row = row0 + ai * 128 + m * 16;
        const float* x = (row < TP ? xp + (size_t)row * 1024 : xs + (size_t)(row - TP) * 1024);
        float sq = 0.f;
#pragma unroll
        for (int bj = 0; bj < 2; ++bj) { const int col = col0 + bj * 128;
          const f32x4 a = *(const f32x4*)(x + col) + acc[ai][bj][m][0], b = *(const f32x4*)(x + col + 4) + acc[ai][bj][m][1];
          float* o = h + (size_t)row * 1024 + col; *(f32x4*)o = a; *(f32x4*)(o + 4) = b;
          st_bf8(hb + (size_t)row * 1024 + col, a, b);
          sq += a[0] * a[0] + a[1] * a[1] + a[2] * a[2] + a[3] * a[3] + b[0] * b[0] + b[1] * b[1] + b[2] * b[2] + b[3] * b[3]; }
        sq += __shfl_xor(sq, 16); sq += __shfl_xor(sq, 32);
        if (fq == 0) atomicAdd(ssq + row, sq);
      }
  }
};
struct EpiUp {
  static constexpr bool SPLIT = false;
  bf16_t* up; float* out; const float* ssq;
  DI void operator()(const f32x4 (&acc)[2][2][4][2], const Unit& u, int wr, int wc, int fr, int fq) const {
    const int row0 = u.pm * 256 + wr * 64 + fr, col0 = u.pn * 256 + wc * 32 + 8 * fq;
#pragma unroll
    for (int ai = 0; ai < 2; ++ai)
#pragma unroll
      for (int m = 0; m < 4; ++m) {
        const int row = row0 + ai * 128 + m * 16;
        const float rs = rsqrtf(ssq[row] * (1.f / 1024.f) + 1e-6f);
        float* co = nullptr;
        if (row < TP) { const int s_ = row & (SEQ - 1); if (s_ >= SEQ - 2) co = out + O_CONVP + ((size_t)(row >> 14) * 2 + (s_ - (SEQ - 2))) * DFF2; }
        else { const int ts = row - TP, s_ = ts & 63; if (s_ >= 62) co = out + O_CONVS + ((size_t)(ts >> 6) * 2 + (s_ - 62)) * DFF2; }
#pragma unroll
        for (int bj = 0; bj < 2; ++bj) { const int col = col0 + bj * 128;
          const f32x4 a = acc[ai][bj][m][0] * rs, b = acc[ai][bj][m][1] * rs;
          st_bf8(up + (size_t)row * DFF2 + col, a, b);
          if (co) { *(f32x4*)(co + col) = a; *(f32x4*)(co + col + 4) = b; } }
      }
  }
};
struct EpiDownTail {
  static constexpr bool SPLIT = false;
  float* y; float* T; unsigned* flag;
  DI void operator()(const f32x4 (&acc)[2][2][4][2], const Unit& u, int wr, int wc, int fr, int fq) const {
    if (u.kofs == 0) {
      pg8::epi_iter(acc, u, wr, wc, fr, fq, [&](int row, int col, f32x4 a, f32x4 b) {
        float* o = y + (size_t)row * 1024 + col; *(f32x4*)o = *(const f32x4*)o + a; *(f32x4*)(o + 4) = *(const f32x4*)(o + 4) + b; });
    } else {
      pg8::epi_iter(acc, u, wr, wc, fr, fq, [&](int row, int col, f32x4 a, f32x4 b) {
        float* o = T + (size_t)row * 1024 + col; *(f32x4*)o = a; *(f32x4*)(o + 4) = b; });
      if (threadIdx.x == 0) flag[u.pm * 4 + u.pn] = 1u;
    }
  }
};
struct EpiDown {
  static constexpr bool SPLIT = false;
  float* y;
  DI void operator()(const f32x4 (&acc)[2][2][4][2], const Unit& u, int wr, int wc, int fr, int fq) const {
    pg8::epi_iter(acc, u, wr, wc, fr, fq, [&](int row, int col, f32x4 a, f32x4 b) {
      float* o = y + (size_t)row * 1024 + col;
      *(f32x4*)o = *(const f32x4*)o + a; *(f32x4*)(o + 4) = *(const f32x4*)(o + 4) + b; });
  }
};

namespace att {
constexpr int KVBLK = 64;
constexpr float SCALE = 0.07216878364870322f;
constexpr float THR = 8.f;
constexpr int LDQ = 1536, LDK = 1024, LDO = 1024;
constexpr int SHM_V = 64 * 128 * 2, SHM_K = 64 * 384;
#define KSWZ(row, colB) ((row) * 384 + ((colB) ^ ((((row) >> 1) & 7) << 4)))
#define SBAR() __builtin_amdgcn_sched_barrier(0)
DI int crow(int r, int hi) { return (r & 3) + 8 * (r >> 2) + 4 * hi; }
DI void partialSM(f32x16& p0, f32x16& p1, float& m_reg, float& mn, float& alpha) {
  constexpr float C = SCALE * 1.4426950408889634f;
  float pmax = p0[0];
#pragma unroll
  for (int r = 1; r < 16; ++r) pmax = fmaxf(pmax, p0[r]);
#pragma unroll
  for (int r = 0; r < 16; ++r) pmax = fmaxf(pmax, p1[r]);
  { auto rr = __builtin_amdgcn_permlane32_swap(__float_as_uint(pmax), __float_as_uint(pmax), false, false);
    pmax = fmaxf(__uint_as_float(rr[0]), __uint_as_float(rr[1])); }
  if (__builtin_expect(__all(pmax - m_reg <= THR / SCALE), 1)) { mn = m_reg; alpha = 1.f; }
  else { mn = fmaxf(m_reg, pmax); alpha = __builtin_amdgcn_exp2f((m_reg - mn) * C); m_reg = mn; }
  const float mnC = -mn * C;
#pragma unroll
  for (int r = 0; r < 16; ++r) p0[r] = fmaf(p0[r], C, mnC);
#pragma unroll
  for (int r = 0; r < 16; ++r) p1[r] = fmaf(p1[r], C, mnC);
#pragma unroll
  for (int r = 0; r < 16; ++r) p0[r] = __builtin_amdgcn_exp2f(p0[r]);
}
DI void finishSM(f32x16& p0, f32x16& p1, float alpha, float& l_reg, bf16x8& pa0, bf16x8& pa1, bf16x8& pa2, bf16x8& pa3) {
#pragma unroll
  for (int r = 0; r < 16; ++r) p1[r] = __builtin_amdgcn_exp2f(p1[r]);
  float ps = 0;
#pragma unroll
  for (int r = 0; r < 16; ++r) ps += p0[r];
#pragma unroll
  for (int r = 0; r < 16; ++r) ps += p1[r];
  { auto rr = __builtin_amdgcn_permlane32_swap(__float_as_uint(ps), __float_as_uint(ps), false, false);
    ps = __uint_as_float(rr[0]) + __uint_as_float(rr[1]); }
  l_reg = l_reg * alpha + ps;
#define PK4(P, BASE, OUT) do { unsigned a0 = cvt_pk(P[BASE + 0], P[BASE + 1]), a1 = cvt_pk(P[BASE + 2], P[BASE + 3]);   \
    unsigned b0 = cvt_pk(P[BASE + 4], P[BASE + 5]), b1 = cvt_pk(P[BASE + 6], P[BASE + 7]);                              \
    auto r0 = __builtin_amdgcn_permlane32_swap(a0, b0, false, false); auto r1 = __builtin_amdgcn_permlane32_swap(a1, b1, false, false); \
    u32x4 w = {r0[0], r1[0], r0[1], r1[1]}; OUT = *reinterpret_cast<bf16x8*>(&w); } while (0)
  PK4(p0, 0, pa0); PK4(p0, 8, pa1); PK4(p1, 0, pa2); PK4(p1, 8, pa3);
#undef PK4
}
template <int OFF> DI bf16x8 lds_rd128(int addr) { bf16x8 r; asm volatile("ds_read_b128 %0, %1 offset:%2" : "=&v"(r) : "v"(addr), "i"(OFF) : "memory"); return r; }
#define QK_RD(S, D0) do { ka[S] = lds_rd128<((D0) >> 2) * 128>(kb[(D0) & 3]); kc[S] = lds_rd128<((D0) >> 2) * 128 + 12288>(kb[(D0) & 3]); } while (0)
#define QK_STEP(D0, S, WAITN) do { asm volatile("s_waitcnt lgkmcnt(" #WAITN ")" ::: "memory"); SBAR(); \
    p0 = __builtin_amdgcn_mfma_f32_32x32x16_bf16(ka[S], qr[D0], p0, 0, 0, 0); p1 = __builtin_amdgcn_mfma_f32_32x32x16_bf16(kc[S], qr[D0], p1, 0, 0, 0); SBAR(); } while (0)
DI void qkt(f32x16& p0, f32x16& p1, const int (&kb)[4], const bf16x8* qr) {
  p0 = f32x16{}; p1 = f32x16{};
  bf16x8 ka[5], kc[5];
  QK_RD(0, 0); QK_RD(1, 1); QK_RD(2, 2); QK_RD(3, 3); QK_RD(4, 4);
  QK_STEP(0, 0, 8); QK_RD(0, 5);
  QK_STEP(1, 1, 8); QK_RD(1, 6);
  QK_STEP(2, 2, 8); QK_RD(2, 7);
  QK_STEP(3, 3, 8); QK_RD(3, 8);
  QK_STEP(4, 4, 8); QK_RD(4, 9);
  QK_STEP(5, 0, 8); QK_RD(0, 10);
  QK_STEP(6, 1, 8); QK_RD(1, 11);
  QK_STEP(7, 2, 8);
  QK_STEP(8, 3, 6);
  QK_STEP(9, 4, 4);
  QK_STEP(10, 0, 2);
  QK_STEP(11, 1, 0);
}
#undef QK_RD
#undef QK_STEP
DI int v_st(int k, int c) { const int kk = (k & ~0xC) | ((k & 4) << 1) | ((k & 8) >> 1); return ((kk >> 3) * 4 + (c >> 5)) * 512 + ((kk & 7) * 32 + (c & 31)) * 2; }
DI int v_rd_base(int lane) { return ((lane & 3) << 3) | (((lane >> 2) & 3) << 6) | (((lane >> 4) & 1) << 5) | (((lane >> 5) & 1) << 8); }
constexpr int v_rd_off(int d0, int ks, int half) { return d0 * 512 + ks * 4096 + half * 2048; }
template <int OFF> DI s16x4 tr_read(int vb) {
  s16x4 r; asm volatile("ds_read_b64_tr_b16 %0, %1 offset:%2" : "=&v"(r) : "v"(vb), "i"(OFF) : "memory"); return r;
}
#define PK(L, H) (bf16x8){L[0], L[1], L[2], L[3], H[0], H[1], H[2], H[3]}
#define PV_RD(SET, D0, KS) do { rl[SET][0] = tr_read<v_rd_off(D0, KS, 0)>(vb); rh[SET][0] = tr_read<v_rd_off(D0, KS, 1)>(vb); \
    rl[SET][1] = tr_read<v_rd_off(D0, (KS) + 1, 0)>(vb); rh[SET][1] = tr_read<v_rd_off(D0, (KS) + 1, 1)>(vb); } while (0)
#define PV_MM(SET, D0, PA, PB, WAITN) do { asm volatile("s_waitcnt lgkmcnt(" #WAITN ")" ::: "memory"); SBAR(); \
    o[D0] = __builtin_amdgcn_mfma_f32_32x32x16_bf16(PA, PK(rl[SET][0], rh[SET][0]), o[D0], 0, 0, 0); \
    o[D0] = __builtin_amdgcn_mfma_f32_32x32x16_bf16(PB, PK(rl[SET][1], rh[SET][1]), o[D0], 0, 0, 0); SBAR(); } while (0)
DI void pv_d0(f32x16* o, int vb, bf16x8 pa0, bf16x8 pa1, bf16x8 pa2, bf16x8 pa3) {
  s16x4 rl[3][2], rh[3][2];
  PV_RD(0, 0, 0); PV_RD(1, 0, 2);
  PV_RD(2, 1, 0); PV_MM(0, 0, pa0, pa1, 8);
  PV_RD(0, 1, 2); PV_MM(1, 0, pa2, pa3, 8);
  PV_RD(1, 2, 0); PV_MM(2, 1, pa0, pa1, 8);
  PV_RD(2, 2, 2); PV_MM(0, 1, pa2, pa3, 8);
  PV_RD(0, 3, 0); PV_MM(1, 2, pa0, pa1, 8);
  PV_RD(1, 3, 2); PV_MM(2, 2, pa2, pa3, 8);
  PV_MM(0, 3, pa0, pa1, 4);
  PV_MM(1, 3, pa2, pa3, 0);
}
#undef PV_RD
#undef PV_MM
#undef PK

DI void attn_body(const bf16_t* __restrict__ Qw, const bf16_t* __restrict__ Kh, const bf16_t* __restrict__ Vh, const bf16_t* __restrict__ Kr,
                  bf16_t* __restrict__ Ow, int NT, int kvis, bool act, unsigned char* lds) {
  const int tid = get_tid(), wid = tid >> 6, lane = tid & 63, r32 = lane & 31, hi = lane >> 5;
  unsigned char* V_lds = lds; unsigned char* K_lds = lds + 3 * SHM_V;
  float* wsl = (float*)(lds + 3 * SHM_V + 2 * SHM_K) + wid * 64; float* li_l = wsl; float* al_l = wsl + 32;
  float m_reg = -1e30f, l_reg = 0; f32x16 o[4] = {}; bf16x8 qr[12];
  const bf16_t* Ql = Qw + (size_t)r32 * LDQ + hi * 8;
#pragma unroll
  for (int d0 = 0; d0 < 12; ++d0) qr[d0] = *reinterpret_cast<const bf16x8*>(Ql + d0 * 16);
  const int vb0 = (int)(uintptr_t)(LAS unsigned char*)V_lds + v_rd_base(lane);
  const int wu = __builtin_amdgcn_readfirstlane(wid);
  int koff[3], voff[2];
#pragma unroll
  for (int i = 0; i < 3; ++i) { const int L = 1024 * (wu * 3 + i) + 16 * lane, row = L / 384, cs = (L - row * 384) >> 4, c16 = cs ^ ((row >> 1) & 7);
    koff[i] = c16 < 16 ? row * 1024 + c16 * 8 : (int)(0x80000000u | (unsigned)(row * 64 + (c16 - 16) * 8)); }
#pragma unroll
  for (int i = 0; i < 2; ++i) { const int L = 1024 * (wu * 2 + i) + 16 * lane, sub = L >> 9, within = (L & 511) >> 1, kk = (sub >> 2) * 8 + (within >> 5), cl = within & 31;
    const int k = (kk & ~0xC) | ((kk & 4) << 1) | ((kk & 8) >> 1); voff[i] = k * 1024 + (sub & 3) * 32 + cl; }
  LAS unsigned char* Kd = (LAS unsigned char*)K_lds + wu * 3072; LAS unsigned char* Vd = (LAS unsigned char*)V_lds + wu * 2048;
#define SLOAD(k0, kbuf, vbuf) do { \
    _Pragma("unroll") for (int _i = 0; _i < 3; ++_i) { const bf16_t* _s = koff[_i] < 0 ? Kr + (size_t)(k0) * 64 + (koff[_i] & 0x7fffffff) : Kh + (size_t)(k0) * LDK + koff[_i]; \
      __builtin_amdgcn_global_load_lds((const unsigned*)_s, (LAS unsigned*)(Kd + (kbuf) * SHM_K + _i * 1024), 16, 0, 0); } \
    _Pragma("unroll") for (int _i = 0; _i < 2; ++_i) { const bf16_t* _s = Vh + (size_t)(k0) * LDK + voff[_i]; \
      __builtin_amdgcn_global_load_lds((const unsigned*)_s, (LAS unsigned*)(Vd + (vbuf) * SHM_V + _i * 1024), 16, 0, 0); } } while (0)
#define SWAIT() asm volatile("s_waitcnt vmcnt(0)" ::: "memory")
#define RESC(a) do { if (__any((a) < 1.f)) { if (hi == 0) al_l[r32] = (a); asm volatile("s_waitcnt lgkmcnt(0)" ::: "memory"); \
    _Pragma("unroll") for (int d = 0; d < 4; ++d) _Pragma("unroll") for (int r = 0; r < 16; ++r) o[d][r] *= al_l[crow(r, hi)]; } } while (0)
#define MASKP(P0, P1, tile) do { if (__builtin_expect((tile) >= kvis_u, 0)) { _Pragma("unroll") for (int r = 0; r < 16; ++r) { P0[r] = -1e30f; P1[r] = -1e30f; } } } while (0)
  const int kvis_u = __builtin_amdgcn_readfirstlane(kvis);
  f32x16 p0, p1; float mn, al = 1.f; bf16x8 pa0, pa1, pa2, pa3;
  int kbr[4];
  { const int f = (r32 >> 1) & 7;
#pragma unroll
    for (int q = 0; q < 4; ++q) kbr[q] = (int)(uintptr_t)(LAS unsigned char*)K_lds + r32 * 384 + ((((q << 1) | hi) ^ f) << 4); }
  SLOAD(0, 0, 0); SWAIT(); __syncthreads();
  for (int j = 0; j < NT; ++j) {
    const int bsel = j & 1;
    if (j + 1 < NT) SLOAD((j + 1) * KVBLK, bsel ^ 1, bsel ^ 1);
    SBAR();
    if (act && j < kvis_u) {
      int kb[4];
#pragma unroll
      for (int q = 0; q < 4; ++q) kb[q] = kbr[q] + bsel * SHM_K;
      qkt(p0, p1, kb, qr);
      partialSM(p0, p1, m_reg, mn, al);
      RESC(al);
      finishSM(p0, p1, al, l_reg, pa0, pa1, pa2, pa3); SBAR();
      pv_d0(o, vb0 + bsel * SHM_V, pa0, pa1, pa2, pa3);
    }
    SBAR();
    SWAIT();
    __syncthreads();
  }
  if (act) {
    if (hi == 0) li_l[r32] = l_reg;
    asm volatile("s_waitcnt lgkmcnt(0)" ::: "memory");
    float rli[16];
#pragma unroll
    for (int r = 0; r < 16; ++r) rli[r] = __builtin_amdgcn_rcpf(li_l[crow(r, hi)]);
#pragma unroll
    for (int r = 0; r < 16; ++r) { const int orow = crow(r, hi);
#pragma unroll
      for (int d0 = 0; d0 < 4; ++d0) Ow[(size_t)orow * LDO + d0 * 32 + r32] = f2bf(o[d0][r] * rli[r]); }
  }
#undef SLOAD
#undef SWAIT
#undef RESC
#undef MASKP
}
}

#define XB_XCNT(j) (64 * (j))
#define XB_XSUB(j) (1024 + 64 * (j))
#define XB_XGEN(j) (2048 + 64 * (j))
#define XB_TOP 3072
#define XB_TOPGEN 3136
DI unsigned xb_ld(unsigned* p) { return __hip_atomic_load(p, __ATOMIC_RELAXED, __HIP_MEMORY_SCOPE_AGENT); }
DI unsigned xb_add(unsigned* p, unsigned v) { return __hip_atomic_fetch_add(p, v, __ATOMIC_RELAXED, __HIP_MEMORY_SCOPE_AGENT); }
DI void xb_st(unsigned* p, unsigned v) { __hip_atomic_store(p, v, __ATOMIC_RELAXED, __HIP_MEMORY_SCOPE_AGENT); }
DI unsigned xb_xcc_id() { return (unsigned)__builtin_amdgcn_s_getreg((3 << 11) | 20) & 0xFu; }
struct GBar { unsigned* bar; unsigned x, nloc, nx, k; };
#define XB_SPINW(cond) do { unsigned _sp = 0; while (cond) { __builtin_amdgcn_s_sleep(1); if (++_sp > (1u << 22)) break; } } while (0)
DI void gbar(GBar& g) {
  asm volatile("s_waitcnt vmcnt(0)" ::: "memory");
  __syncthreads();
  g.k += 1;
  if (threadIdx.x == 0) {
    const unsigned k = g.k;
    const unsigned prev = xb_add(&g.bar[XB_XSUB(g.x)], 1u);
    if (prev + 1u == g.nloc * k) {
      __builtin_amdgcn_fence(__ATOMIC_RELEASE, "agent");
      asm volatile("s_waitcnt vmcnt(0)" ::: "memory");
      const unsigned pt = xb_add(&g.bar[XB_TOP], 1u);
      if (pt + 1u == g.nx * k) xb_st(&g.bar[XB_TOPGEN], k);
      else XB_SPINW(xb_ld(&g.bar[XB_TOPGEN]) < k);
      xb_st(&g.bar[XB_XGEN(g.x)], k);
    } else XB_SPINW(xb_ld(&g.bar[XB_XGEN(g.x)]) < k);
    __builtin_amdgcn_fence(__ATOMIC_ACQUIRE, "agent");
    asm volatile("s_waitcnt vmcnt(0)" ::: "memory");
  }
  __syncthreads();
}

DI int colmap(int mode, int n, int coloff) {
  if (mode == 0) return n + coloff;
  if (mode == 1) { if (n < 3072) return n; if (n < 3136) { const int p = n - 3072; return 3072 + (p & 1) * 32 + (p >> 1); } return -1; }
  const int h = n / 192, d = n - h * 192; if (d < 128) return n; const int p = d - 128; return h * 192 + 128 + (p & 1) * 32 + (p >> 1);
}
DI void transpose_tile(const float* __restrict__ src, int ld, int K, int k0, int n0, int mode, int coloff, bf16_t* __restrict__ dst, float* tl, const float* __restrict__ kscale) {
  const int tid = get_tid();
  const bool plain = mode == 0 || (mode == 1 && n0 + 64 <= 3072) || (mode == 2 && (n0 % 192) != 128);
  if (plain) {
    const int kk = tid >> 4, n4 = (tid & 15) * 4;
#pragma unroll
    for (int i = 0; i < 2; ++i) { const int k = kk + 32 * i; f32x4 w = *(const f32x4*)(src + (size_t)(k0 + k) * ld + coloff + n0 + n4);
      if (kscale) w = w * kscale[k0 + k];
      tl[k * 65 + n4] = w[0]; tl[k * 65 + n4 + 1] = w[1]; tl[k * 65 + n4 + 2] = w[2]; tl[k * 65 + n4 + 3] = w[3]; }
    __syncthreads();
    const int n = tid >> 3, kc = (tid & 7) * 8;
    f32x4 a, b;
#pragma unroll
    for (int i = 0; i < 4; ++i) { a[i] = tl[(kc + i) * 65 + n]; b[i] = tl[(kc + 4 + i) * 65 + n]; }
    st_bf8(dst + (size_t)(n0 + n) * K + k0 + kc, a, b);
    __syncthreads();
    return;
  }
  const int tx = tid & 63, ty = tid >> 6;
  const int sc = colmap(mode, n0 + tx, coloff);
#pragma unroll
  for (int i = 0; i < 8; ++i) { const int k = ty * 8 + i; const float w = sc >= 0 ? src[(size_t)(k0 + k) * ld + sc] : 0.f; tl[k * 65 + tx] = kscale ? w * kscale[k0 + k] : w; }
  __syncthreads();
#pragma unroll
  for (int i = 0; i < 8; ++i) { const int nn = ty * 8 + i; dst[(size_t)(n0 + nn) * K + k0 + tx] = f2bf(tl[tx * 65 + nn]); }
  __syncthreads();
}
DI void phase0(const Params& p, unsigned char* shm) {
  const int tid = get_tid(), wid = tid >> 6, lane = tid & 63, nblk = gridDim.x, bid = get_bid();
  if (bid == 0 && tid < 64) ((unsigned*)(p.ws + OFF_CNT))[tid] = 0u;
  if (tid == 0) xb_add((unsigned*)(p.ws + OFF_BAR) + XB_XCNT(xb_xcc_id()), 1u);
  float* tl = (float*)shm;
  for (int it = bid; it < 4672; it += nblk) {
    const float* src; const float* ksc = nullptr; int ld, K, ktiles, mode = 0, coloff = 0, base; size_t doff;
    if (it < 832) { src = p.in[6]; ld = INC; K = 1024; mode = 1; base = 0; doff = OFF_WIN; }
    else if (it < 1344) { src = p.in[6]; ld = INC; K = 1024; coloff = OFFG; base = 832; doff = OFF_WG; }
    else if (it < 1536) { src = p.in[12]; ld = 1536; K = 512; mode = 2; base = 1344; doff = OFF_WUQ; ksc = p.in[11]; }
    else if (it < 1664) { src = p.in[14]; ld = 1024; K = 512; base = 1536; doff = OFF_WKV; }
    else if (it < 1792) { src = p.in[15]; ld = 1024; K = 512; base = 1664; doff = OFF_WKV + (size_t)1024 * 512 * 2; }
    else if (it < 2048) { src = p.in[16]; ld = 1024; K = 1024; base = 1792; doff = OFF_WPA; }
    else if (it < 2304) { src = p.in[17]; ld = 1024; K = 1024; base = 2048; doff = OFF_WPB; }
    else if (it < 2560) { src = p.in[18]; ld = 1024; K = 1024; base = 2304; doff = OFF_WOUT; }
    else if (it < 3968) { src = p.in[20]; ld = DFF2; K = 1024; base = 2560; doff = OFF_WUP; ksc = p.in[19]; }
    else { src = p.in[23]; ld = 1024; K = DFF; base = 3968; doff = OFF_WDN; }
    ktiles = K / 64;
    const int li = it - base, kt = li % ktiles, ntile = li / ktiles;
    transpose_tile(src, ld, K, kt * 64, ntile * 64, mode, coloff, (bf16_t*)(p.ws + doff), tl, ksc);
  }
  const int gw = bid * 8 + wid, nw = nblk * 8;
  { const float* g = p.in[5]; bf16_t* xn = (bf16_t*)(p.ws + OFF_XN);
    f32x4 gv[4];
#pragma unroll
    for (int i = 0; i < 4; ++i) gv[i] = *(const f32x4*)(g + lane * 4 + i * 256);
    for (int t = gw; t < TT; t += 2 * nw) {
      const int t2 = t + nw; const bool has2 = t2 < TT;
      const float* x = xrow(p, t); const float* x2 = xrow(p, has2 ? t2 : t); f32x4 v[4], w[4]; float ss = 0, ss2 = 0;
#pragma unroll
      for (int i = 0; i < 4; ++i) { v[i] = *(const f32x4*)(x + lane * 4 + i * 256); w[i] = *(const f32x4*)(x2 + lane * 4 + i * 256); }
#pragma unroll
      for (int i = 0; i < 4; ++i) { ss += v[i][0] * v[i][0] + v[i][1] * v[i][1] + v[i][2] * v[i][2] + v[i][3] * v[i][3]; ss2 += w[i][0] * w[i][0] + w[i][1] * w[i][1] + w[i][2] * w[i][2] + w[i][3] * w[i][3]; }
      ss = wave_sum(ss); ss2 = wave_sum(ss2);
      const float rs = rsqrtf(ss * (1.f / 1024.f) + 1e-6f), rs2 = rsqrtf(ss2 * (1.f / 1024.f) + 1e-6f);
#pragma unroll
      for (int i = 0; i < 4; ++i) { u32x2 o; o.x = cvt_pk(v[i][0] * rs * gv[i][0], v[i][1] * rs * gv[i][1]); o.y = cvt_pk(v[i][2] * rs * gv[i][2], v[i][3] * rs * gv[i][3]);
        *(u32x2*)(xn + (size_t)t * 1024 + lane * 4 + i * 256) = o;
        if (has2) { u32x2 o2; o2.x = cvt_pk(w[i][0] * rs2 * gv[i][0], w[i][1] * rs2 * gv[i][1]); o2.y = cvt_pk(w[i][2] * rs2 * gv[i][2], w[i][3] * rs2 * gv[i][3]);
          *(u32x2*)(xn + (size_t)t2 * 1024 + lane * 4 + i * 256) = o2; } }
    } }
  { const float* c = p.in[2]; bf16_t* ca = (bf16_t*)(p.ws + OFF_CKV);
    const int total = NBS * KVS * 64;
#pragma unroll 4
    for (int i = bid * 512 + tid; i < total; i += nblk * 512) {
      const int r = i >> 6, l8 = (i & 63) * 8; const int b = r / KVS, s = r - b * KVS;
      bf16_t* d = ca + ((size_t)TP + r) * 512 + l8;
      if (s < PAST) { const float* x = c + ((size_t)b * PAST + s) * 512 + l8; st_bf8(d, *(const f32x4*)x, *(const f32x4*)(x + 4)); }
      else if (s >= PAST + 64) { *(u32x4*)d = (u32x4){0u, 0u, 0u, 0u}; }
    } }
  { const float* c = p.in[3]; bf16_t* ka = (bf16_t*)((unsigned char*)p.out + OB_KR);
    const int total = NBS * KVS * 8;
#pragma unroll 2
    for (int i = bid * 512 + tid; i < total; i += nblk * 512) {
      const int r = i >> 3, o8 = (i & 7) * 8; const int b = r / KVS, s = r - b * KVS;
      bf16_t* d = ka + ((size_t)TP + r) * 64 + o8;
      if (s < PAST) { const float* x = c + ((size_t)b * PAST + s) * 64 + (o8 >> 1); const f32x4 lo = *(const f32x4*)x, hi4 = *(const f32x4*)(x + 32);
        st_bf8(d, (f32x4){lo[0], hi4[0], lo[1], hi4[1]}, (f32x4){lo[2], hi4[2], lo[3], hi4[3]}); }
      else if (s >= PAST + 64) { *(u32x4*)d = (u32x4){0u, 0u, 0u, 0u}; }
    } }
  { float* sq = (float*)(p.ws + OFF_SSQ); for (int i = bid * 512 + tid; i < TT; i += nblk * 512) sq[i] = 0.f; }
  { float* st = (float*)(p.ws + OFF_STAT); for (int i = bid * 512 + tid; i < 3 * TT; i += nblk * 512) st[i] = 0.f; }
  if (bid == 1) { unsigned* tf = (unsigned*)(p.ws + OFF_TFLAG); for (int i = tid; i < 1024; i += 512) tf[i] = 0u; }
  { float2* tb = (float2*)(p.ws + OFF_ROPE);
    for (int i = bid * 512 + tid; i < 16384 * 32; i += nblk * 512) {
      const int pos = i >> 5, k = i & 31;
      const double inv = exp(-(double)k * (9.210340371976184 / 32.0));
      const double ang = (double)pos * inv;
      tb[i] = make_float2((float)cos(ang), (float)sin(ang));
    } }
  { const float* w = p.in[9]; bf16_t* wb = (bf16_t*)(p.ws + OFF_WSB);
    for (int i = bid * 512 + tid; i < 8 * 128 * 128; i += nblk * 512) { const int t = (i >> 7) & 127, s = i & 127; wb[i] = s <= t ? f2bf(w[i]) : (bf16_t)0; } }
}

DI void phase2(const Params& p) {
  const int tid = get_tid(), wid = tid >> 6, lane = tid & 63, nblk = gridDim.x, bid = get_bid();
  const int gw = bid * 8 + wid, nw = nblk * 8;
  bf16_t* ca = (bf16_t*)(p.ws + OFF_CKV); const float* kg = p.in[13];
  const f32x4 g0 = *(const f32x4*)(kg + lane * 8), g1 = *(const f32x4*)(kg + lane * 8 + 4);
  for (int t = gw; t < TT; t += 2 * nw) {
    const int t2 = t + nw; const bool has2 = t2 < TT;
    float* r0 = ckv_out(p.out, t) + lane * 8; float* r1 = ckv_out(p.out, has2 ? t2 : t) + lane * 8;
    f32x4 a0 = *(const f32x4*)r0, a1 = *(const f32x4*)(r0 + 4), c0 = *(const f32x4*)r1, c1 = *(const f32x4*)(r1 + 4);
    float ss = a0[0] * a0[0] + a0[1] * a0[1] + a0[2] * a0[2] + a0[3] * a0[3] + a1[0] * a1[0] + a1[1] * a1[1] + a1[2] * a1[2] + a1[3] * a1[3];
    float s2 = c0[0] * c0[0] + c0[1] * c0[1] + c0[2] * c0[2] + c0[3] * c0[3] + c1[0] * c1[0] + c1[1] * c1[1] + c1[2] * c1[2] + c1[3] * c1[3];
    ss = wave_sum(ss); s2 = wave_sum(s2);
    const float rs = rsqrtf(ss * (1.f / 512.f) + 1e-6f), rs2 = rsqrtf(s2 * (1.f / 512.f) + 1e-6f);
    a0 = a0 * rs * g0; a1 = a1 * rs * g1;
    *(f32x4*)r0 = a0; *(f32x4*)(r0 + 4) = a1;
    st_bf8(ca + (size_t)tok_kvrow(t) * 512 + lane * 8, a0, a1);
    if (has2) { c0 = c0 * rs2 * g0; c1 = c1 * rs2 * g1;
      *(f32x4*)r1 = c0; *(f32x4*)(r1 + 4) = c1;
      st_bf8(ca + (size_t)tok_kvrow(t2) * 512 + lane * 8, c0, c1); }
  }
}

DI void spatial_phase(const Params& p, unsigned char* shm) {
  const int tid = get_tid(), wid = tid >> 6, lane = tid & 63, r32 = lane & 31, hi = lane >> 5, nblk = gridDim.x, bid = get_bid();
  const bf16_t* v = (const bf16_t*)(p.ws + OFF_V); bf16_t* ua = (bf16_t*)(p.ws + OFF_UA); const bf16_t* wsb = (const bf16_t*)(p.ws + OFF_WSB);
  const float* bs = p.in[10]; const float* lng = p.in[7]; const float* lnb = p.in[8]; const float* vstat = (const float*)(p.ws + OFF_STAT);
  const int sr = tid >> 4, sc = (tid & 15) * 8, vst0 = att::v_st(sr, sc), vst1 = att::v_st(32 + sr, sc);
  const int vbase = (int)(uintptr_t)(LAS unsigned char*)shm + att::v_rd_base(lane);
  const int gsel = wid >> 2, tb = wid & 3;
  for (int it = bid; it < (256 + 32) * 4; it += nblk) {
    const int ch = it >> 2, gp = it & 3;
    int row0, nrows;
    if (ch < 256) { row0 = ch * 128; nrows = 128; } else { row0 = TP + (ch - 256) * 64; nrows = 64; }
    __syncthreads();
#pragma unroll
    for (int gs = 0; gs < 2; ++gs)
#pragma unroll
      for (int sh = 0; sh < 2; ++sh) {
        if (sh * 64 < nrows) {
          const int c0 = (gp * 2 + gs) * 128 + sc;
          const f32x4 g0 = *(const f32x4*)(lng + c0), g1 = *(const f32x4*)(lng + c0 + 4), b0 = *(const f32x4*)(lnb + c0), b1 = *(const f32x4*)(lnb + c0 + 4);
          unsigned char* d = shm + (gs * 2 + sh) * 16384;
#pragma unroll
          for (int rr_ = 0; rr_ < 2; ++rr_) {
            const int r = row0 + sh * 64 + sr + 32 * rr_;
            const u32x4 w = *(const u32x4*)(v + (size_t)r * 1024 + c0);
            const float mean = vstat[r] * (1.f / 1024.f), var = fmaxf(vstat[TT + r] * (1.f / 1024.f) - mean * mean, 0.f), rs = rsqrtf(var + 1e-6f);
            f32x4 x0 = {bflo(w.x), bfhi(w.x), bflo(w.y), bfhi(w.y)}, x1 = {bflo(w.z), bfhi(w.z), bflo(w.w), bfhi(w.w)};
            x0 = (x0 - mean) * rs * g0 + b0; x1 = (x1 - mean) * rs * g1 + b1;
            u32x4 o_; o_.x = cvt_pk(x0[0], x0[1]); o_.y = cvt_pk(x0[2], x0[3]); o_.z = cvt_pk(x1[0], x1[1]); o_.w = cvt_pk(x1[2], x1[3]);
            *(u32x4*)(d + (rr_ ? vst1 : vst0)) = o_;
            if (r >= TP) { float* go = p.out + O_GV + (size_t)(r - TP) * 1024 + c0; *(f32x4*)go = x0; *(f32x4*)(go + 4) = x1; }
          }
        } }
    __syncthreads();
    if (tb * 32 < nrows) {
      const int g = gp * 2 + gsel;
      f32x16 o[4] = {};
      const int nsh = tb >= 2 ? 2 : 1;
      for (int sh = 0; sh < nsh; ++sh) {
        const bf16_t* wrow = wsb + ((size_t)g * 128 + tb * 32 + r32) * 128 + sh * 64 + hi * 8;
        const bf16x8 pa0 = *(const bf16x8*)(wrow), pa1 = *(const bf16x8*)(wrow + 16), pa2 = *(const bf16x8*)(wrow + 32), pa3 = *(const bf16x8*)(wrow + 48);
        att::pv_d0(o, vbase + (gsel * 2 + sh) * 16384, pa0, pa1, pa2, pa3);
      }
#pragma unroll
      for (int r = 0; r < 16; ++r) { const int t = tb * 32 + att::crow(r, hi); const float bb = bs[g * 128 + t];
#pragma unroll
        for (int d0 = 0; d0 < 4; ++d0) { bf16_t* e = ua + (size_t)(row0 + t) * 1024 + g * 128 + d0 * 32 + r32; *e = f2bf(bf2f(*e) * (o[d0][r] + bb)); } }
    }
  }
  __syncthreads();
}

DI void attn_phase(const Params& p, unsigned char* shm, int ci = 0) {
  const int tid = get_tid(), wid = tid >> 6;
  unsigned* cnt = (unsigned*)(p.ws + OFF_CNT) + ci;
  volatile int* s_item = (volatile int*)(shm + 3 * att::SHM_V + 2 * att::SHM_K + 8 * 64 * 4);
  const bf16_t* q = (const bf16_t*)((unsigned char*)p.out + OB_Q); const bf16_t* kr = (const bf16_t*)((unsigned char*)p.out + OB_KR);
  const bf16_t* kb = (const bf16_t*)(p.ws + OFF_KB); const bf16_t* vb = (const bf16_t*)(p.ws + OFF_VB); bf16_t* ao = (bf16_t*)(p.ws + OFF_ATTN);
  for (;;) {
    __syncthreads();
    if (tid == 0) *s_item = (int)atomicAdd(cnt, 1u);
    __syncthreads();
    const int it = *s_item;
    if (it >= 1280) break;
    const bool smp_ = it >= 784 && it < 1040; const int si = it - 784, pi_ = it < 784 ? it : it - 256;
    if (smp_) {
      const int b = si >> 3, h = si & 7; const size_t kv0 = (size_t)TP + (size_t)b * KVS; const size_t q0 = (size_t)TP + b * 64 + (wid & 1) * 32;
      att::attn_body(q + q0 * 1536 + h * 192, kb + kv0 * 1024 + h * 128, vb + kv0 * 1024 + h * 128, kr + kv0 * 64,
                     ao + q0 * 1024 + h * 128, 66, 65, wid < 2, shm);
    } else {
      const int i = pi_, qb = 63 - (i >> 4), bh = i & 15, b = bh >> 3, h = bh & 7;
      const size_t kv0 = (size_t)b * SEQ; const size_t q0 = kv0 + qb * 256 + wid * 32;
      att::attn_body(q + q0 * 1536 + h * 192, kb + kv0 * 1024 + h * 128, vb + kv0 * 1024 + h * 128, kr + kv0 * 64,
                     ao + q0 * 1024 + h * 128, 4 * qb + 4, 4 * qb + (wid >> 1) + 1, true, shm);
    }
  }
}

DI void rmsnorm_rows(const Params& p, float* src, const float* g, bf16_t* dst, const float* T, const unsigned* tflag) {
  const int tid = get_tid(), wid = tid >> 6, lane = tid & 63, gw = get_bid() * 8 + wid, nw = gridDim.x * 8;
  f32x4 gv[4];
#pragma unroll
  for (int i = 0; i < 4; ++i) gv[i] = *(const f32x4*)(g + lane * 4 + i * 256);
  for (int t = gw; t < TT; t += 2 * nw) {
    const int t2 = t + nw; const bool has2 = t2 < TT;
    float* x = src + (size_t)t * 1024; float* x2 = src + (size_t)(has2 ? t2 : t) * 1024;
    f32x4 v[4], w[4]; float ss = 0, ss2 = 0;
#pragma unroll
    for (int i = 0; i < 4; ++i) { v[i] = *(const f32x4*)(x + lane * 4 + i * 256); w[i] = *(const f32x4*)(x2 + lane * 4 + i * 256);
      if (T) { if (tflag[(t >> 8) * 4 + i]) v[i] += *(const f32x4*)(T + (size_t)t * 1024 + lane * 4 + i * 256);
               if (has2 && tflag[(t2 >> 8) * 4 + i]) w[i] += *(const f32x4*)(T + (size_t)t2 * 1024 + lane * 4 + i * 256); } }
#pragma unroll
    for (int i = 0; i < 4; ++i) { ss += v[i][0] * v[i][0] + v[i][1] * v[i][1] + v[i][2] * v[i][2] + v[i][3] * v[i][3]; ss2 += w[i][0] * w[i][0] + w[i][1] * w[i][1] + w[i][2] * w[i][2] + w[i][3] * w[i][3]; }
    ss = wave_sum(ss); ss2 = wave_sum(ss2);
    const float rs = rsqrtf(ss * (1.f / 1024.f) + 1e-6f), rs2 = rsqrtf(ss2 * (1.f / 1024.f) + 1e-6f);
#pragma unroll
    for (int i = 0; i < 4; ++i) {
      const f32x4 y = v[i] * rs * gv[i], y2 = w[i] * rs2 * gv[i];
      if (dst) { u32x2 o; o.x = cvt_pk(y[0], y[1]); o.y = cvt_pk(y[2], y[3]); *(u32x2*)(dst + (size_t)t * 1024 + lane * 4 + i * 256) = o;
        if (has2) { u32x2 o2; o2.x = cvt_pk(y2[0], y2[1]); o2.y = cvt_pk(y2[2], y2[3]); *(u32x2*)(dst + (size_t)t2 * 1024 + lane * 4 + i * 256) = o2; } }
      else { __builtin_nontemporal_store(y, (f32x4*)(x + lane * 4 + i * 256)); if (has2) __builtin_nontemporal_store(y2, (f32x4*)(x2 + lane * 4 + i * 256)); }
    }
  }
}

DI void unpack8(const u32x4 w, float (&o)[8]) { o[0] = bflo(w.x); o[1] = bfhi(w.x); o[2] = bflo(w.y); o[3] = bfhi(w.y); o[4] = bflo(w.z); o[5] = bfhi(w.z); o[6] = bflo(w.w); o[7] = bfhi(w.w); }
DI void convgate_phase(const Params& p) {
  const bf16_t* up = (const bf16_t*)(p.ws + OFF_UP); bf16_t* act = (bf16_t*)(p.ws + OFF_ACT);
  const float* cw = p.in[21]; const float* cb = p.in[22];
  const int tid = get_tid(), wid = tid >> 6, lane = tid & 63, gw = get_bid() * 8 + wid, nw = gridDim.x * 8;
  const int nper = nw / 6;
  const int slab = gw % 6, idx = gw / 6;
  const int j8 = (slab * 64 + lane) * 8;
  if (idx >= nper || j8 >= DFF) return;
  float wv[3][8], wg[3][8], bv[8], bg[8];
#pragma unroll
  for (int k = 0; k < 3; ++k) { const f32x4 a = *(const f32x4*)(cw + k * DFF2 + j8), b = *(const f32x4*)(cw + k * DFF2 + j8 + 4), c = *(const f32x4*)(cw + k * DFF2 + DFF + j8), d = *(const f32x4*)(cw + k * DFF2 + DFF + j8 + 4);
#pragma unroll
    for (int j = 0; j < 4; ++j) { wv[k][j] = a[j]; wv[k][4 + j] = b[j]; wg[k][j] = c[j]; wg[k][4 + j] = d[j]; } }
  { const f32x4 a = *(const f32x4*)(cb + j8), b = *(const f32x4*)(cb + j8 + 4), c = *(const f32x4*)(cb + DFF + j8), d = *(const f32x4*)(cb + DFF + j8 + 4);
#pragma unroll
    for (int j = 0; j < 4; ++j) { bv[j] = a[j]; bv[4 + j] = b[j]; bg[j] = c[j]; bg[4 + j] = d[j]; } }
  for (int seg = idx; seg < TT / 8; seg += nper) {
    const int t0 = seg * 8;
    int s0, b; const bool pr = t0 < TP;
    if (pr) { s0 = t0 & (SEQ - 1); b = 0; } else { s0 = (t0 - TP) & 63; b = (t0 - TP) >> 6; }
    u32x4 rv[8], rg[8];
#pragma unroll
    for (int r = 0; r < 8; ++r) { rv[r] = *(const u32x4*)(up + (size_t)(t0 + r) * DFF2 + j8); rg[r] = *(const u32x4*)(up + (size_t)(t0 + r) * DFF2 + DFF + j8); }
    float v2[8], v1[8], g2[8], g1[8];
    if (s0 != 0) {
      unpack8(*(const u32x4*)(up + (size_t)(t0 - 2) * DFF2 + j8), v2); unpack8(*(const u32x4*)(up + (size_t)(t0 - 1) * DFF2 + j8), v1);
      unpack8(*(const u32x4*)(up + (size_t)(t0 - 2) * DFF2 + DFF + j8), g2); unpack8(*(const u32x4*)(up + (size_t)(t0 - 1) * DFF2 + DFF + j8), g1);
    } else if (pr) {
#pragma unroll
      for (int j = 0; j < 8; ++j) { v2[j] = 0.f; v1[j] = 0.f; g2[j] = 0.f; g1[j] = 0.f; }
    } else {
      const float* st = p.in[4] + (size_t)b * 2 * DFF2 + j8;
#pragma unroll
      for (int j = 0; j < 8; ++j) { v2[j] = st[j]; v1[j] = st[DFF2 + j]; g2[j] = st[DFF + j]; g1[j] = st[DFF2 + DFF + j]; }
    }
#pragma unroll
    for (int r = 0; r < 8; ++r) {
      float v0[8], g0[8]; unpack8(rv[r], v0); unpack8(rg[r], g0);
      f32x4 y0, y1;
#pragma unroll
      for (int j = 0; j < 8; ++j) {
        const float cv = bv[j] + v2[j] * wv[0][j] + v1[j] * wv[1][j] + v0[j] * wv[2][j];
        const float cg_ = bg[j] + g2[j] * wg[0][j] + g1[j] * wg[1][j] + g0[j] * wg[2][j];
        const float y = cg_ * sigmoidf_(cg_) * cv;
        if (j < 4) y0[j] = y; else y1[j - 4] = y;
        v2[j] = v1[j]; v1[j] = v0[j]; g2[j] = g1[j]; g1[j] = g0[j];
      }
      st_bf8(act + (size_t)(t0 + r) * DFF + j8, y0, y1);
    }
  }
}


__global__ void __launch_bounds__(512, 2) mega(Params p) {
  extern __shared__ __attribute__((aligned(16))) unsigned char shm[];
  cg::grid_group grid = cg::this_grid();
  LAS unsigned char* lds = (LAS unsigned char*)shm;
  const int nblk = gridDim.x, bid = get_bid();
  unsigned char* ws = p.ws;
  pg8::StaticOrder S;
  GBar gb; gb.bar = (unsigned*)(ws + OFF_BAR); gb.x = xb_xcc_id(); gb.k = 0;

#ifndef PMASK
#define PMASK 0xffff
#endif
#ifndef PROBE_DUP
#define PROBE_DUP -1
#endif
#define PM(b) for (int _r = 0; _r < ((b) == PROBE_DUP ? 2 : 1); ++_r)
  PM(0) phase0(p, shm);
  grid.sync();
  { unsigned nx = 0; for (int j = 0; j < 16; ++j) nx += xb_ld(&gb.bar[XB_XCNT(j)]) != 0u; gb.nx = nx; gb.nloc = xb_ld(&gb.bar[XB_XCNT(gb.x)]); }
  PM(1) { pg8::Gemm g{(const bf16_t*)(ws + OFF_XN), (const bf16_t*)(ws + OFF_WIN), 1024, 1024, TT, NZ, 1024, nullptr, nullptr, 0}; S.init(TT, NZ, nblk, bid);
    EpiZ e{(bf16_t*)(ws + OFF_UA), (bf16_t*)(ws + OFF_V), (bf16_t*)(ws + OFF_QLAT), p.out, (bf16_t*)((unsigned char*)p.out + OB_KR), (const float2*)(ws + OFF_ROPE), (float*)(ws + OFF_STAT)};
    pg8::gemm_phase(lds, g, S, e); }
  gbar(gb);
  PM(2) phase2(p);
  PM(3) spatial_phase(p, shm);
  PM(4) { pg8::Gemm g{(const bf16_t*)(ws + OFF_QLAT), (const bf16_t*)(ws + OFF_WUQ), 512, 512, TT, 1536, 512, nullptr, nullptr, 0}; S.init(TT, 1536, nblk, bid);
    EpiQ e{(bf16_t*)((unsigned char*)p.out + OB_Q), (const float2*)(ws + OFF_ROPE), (const float*)(ws + OFF_STAT) + 2 * TT};
    pg8::gemm_phase(lds, g, S, e); }
  gbar(gb);
  PM(5) { pg8::Gemm g{(const bf16_t*)(ws + OFF_CKV), (const bf16_t*)(ws + OFF_WKV), 512, 512, RALL, 2048, 512, nullptr, nullptr, 0}; S.init(RALL, 2048, nblk, bid);
    EpiKV e{(bf16_t*)(ws + OFF_KB), (bf16_t*)(ws + OFF_VB)};
    pg8::gemm_phase(lds, g, S, e); }
  gbar(gb);
  PM(6) attn_phase(p, shm);
#ifdef PROBE_ATTN2
  gbar(gb);
  attn_phase(p, shm, 1);
#endif
  gbar(gb);
  PM(7) { bf16_t* G = (bf16_t*)(ws + OFF_T1); bf16_t* mg = (bf16_t*)(ws + OFF_MERGED);
    { pg8::Gemm g{(const bf16_t*)(ws + OFF_XN), (const bf16_t*)(ws + OFF_WG), 1024, 1024, TT, 2048, 1024, nullptr, nullptr, 0}; S.init(TT, 2048, nblk, bid); EpiGate e{G}; pg8::gemm_phase(lds, g, S, e); }
    gbar(gb);
    { pg8::Gemm g{(const bf16_t*)(ws + OFF_UA), (const bf16_t*)(ws + OFF_WPA), 1024, 1024, TT, 1024, 2048, (const bf16_t*)(ws + OFF_ATTN), (const bf16_t*)(ws + OFF_WPB), 16}; S.init(TT, 1024, nblk, bid);
      EpiMerged e{G, mg}; pg8::gemm_phase(lds, g, S, e); } }
  gbar(gb);
  PM(8) { pg8::Gemm g{(const bf16_t*)(ws + OFF_MERGED), (const bf16_t*)(ws + OFF_WOUT), 1024, 1024, TT, 1024, 1024, nullptr, nullptr, 0}; S.init(TT, 1024, nblk, bid);
    EpiOut e{p.in[0], p.in[1], p.out + O_Y, (bf16_t*)(ws + OFF_HN), (float*)(ws + OFF_SSQ)}; pg8::gemm_phase(lds, g, S, e); }
  gbar(gb);
  PM(10) { pg8::Gemm g{(const bf16_t*)(ws + OFF_HN), (const bf16_t*)(ws + OFF_WUP), 1024, 1024, TT, DFF2, 1024, nullptr, nullptr, 0}; S.init(TT, DFF2, nblk, bid);
    EpiUp e{(bf16_t*)(ws + OFF_UP), p.out, (const float*)(ws + OFF_SSQ)}; pg8::gemm_phase(lds, g, S, e); }
  gbar(gb);
  PM(11) convgate_phase(p);
  gbar(gb);
  PM(12) { pg8::Gemm g{(const bf16_t*)(ws + OFF_ACT), (const bf16_t*)(ws + OFF_WDN), DFF, DFF, TT, 1024, DFF, nullptr, nullptr, 0}; S.init(TT, 1024, nblk, bid);
    S.lim = 512; EpiDown e{p.out + O_Y}; pg8::gemm_phase(lds, g, S, e);
    pg8::Gemm g2{(const bf16_t*)(ws + OFF_ACT), (const bf16_t*)(ws + OFF_WDN), DFF, DFF, TT, 1024, DFF / 2, nullptr, nullptr, 0};
    S.tail = DFF / 2; EpiDownTail e2{p.out + O_Y, (float*)(ws + OFF_TPART), (unsigned*)(ws + OFF_TFLAG)}; pg8::gemm_phase(lds, g2, S, e2); }
  gbar(gb);
#ifdef PROBE_SYNC
  for (int i = 0; i < 12; ++i) gbar(gb);
#endif
  PM(13) rmsnorm_rows(p, p.out + O_Y, p.in[24], nullptr, (const float*)(ws + OFF_TPART), (const unsigned*)(ws + OFF_TFLAG));
}

constexpr int DYN_LDS = 131072 + 4096;

extern "C" void kernel_launch(void* const* d_in, const int* in_sizes, int n_in, void* d_out, int out_size, void* d_ws, size_t ws_size, hipStream_t stream) {
  static int grid_blocks = 0;
  if (!grid_blocks) {
    if (n_in != 25 || (size_t)out_size != O_END || ws_size < WS_END) { fprintf(stderr, "kernel_launch: unexpected shapes (n_in %d out %d ws %zu need %zu)\n", n_in, out_size, ws_size, WS_END); return; }
    if (hipFuncSetAttribute((const void*)mega, hipFuncAttributeMaxDynamicSharedMemorySize, DYN_LDS) != hipSuccess) { fprintf(stderr, "kernel_launch: LDS attribute failed\n"); return; }
    int dev = 0, cus = 0, per_cu = 0;
    hipGetDevice(&dev);
    hipDeviceGetAttribute(&cus, hipDeviceAttributeMultiprocessorCount, dev);
    hipOccupancyMaxActiveBlocksPerMultiprocessor(&per_cu, mega, 512, DYN_LDS);
    if (per_cu < 1 || cus < 1) { fprintf(stderr, "kernel_launch: occupancy query gave %d blocks/CU on %d CUs\n", per_cu, cus); return; }
    grid_blocks = cus;
  }
  Params p{};
  for (int i = 0; i < 25; ++i) p.in[i] = (const float*)d_in[i];
  p.out = (float*)d_out; p.ws = (unsigned char*)d_ws;
  hipMemsetAsync((unsigned char*)d_ws + OFF_BAR, 0, BAR_BYTES, stream);
  void* args[] = {&p};
  hipError_t e = hipLaunchCooperativeKernel((const void*)mega, dim3(grid_blocks), dim3(512), args, DYN_LDS, stream);
  if (e != hipSuccess) fprintf(stderr, "cooperative launch failed: %s (grid %d)\n", hipGetErrorString(e), grid_blocks);
}
```
